# Optimizing an MI355X kernel written in HIP

```python
import math
import jax, jax.numpy as jnp
from jax import lax
import numpy as np


D_MODEL = 1024
BATCH = 16
SEQ = 2048
DEPTH = 4

N_MIXERS = 3
N_A_LAYERS = (DEPTH + 2) // 3
N_B_LAYERS = (DEPTH + 1) // 3
N_C_LAYERS = DEPTH // 3
RMS_EPS = 1e-6

A_EXPAND = 128
A_HEADS = D_MODEL // A_EXPAND
A_HEAD_V = D_MODEL // A_HEADS
A_CHUNK = 64

B_HEAD_DIM = 128
B_HEADS = D_MODEL // B_HEAD_DIM
B_BLOCK = 256
B_TOPK = 3
B_QUERY_BLOCK = 128

REL_BUCKETS = 32
REL_MAX_DISTANCE = 1024

C_WINDOWS = (2, 4, 8, 16)
C_GROUPS = len(C_WINDOWS)
C_GROUP_DIM = D_MODEL // C_GROUPS

D_FF = 4 * D_MODEL

kernel_name = "hybrid_hgrn2_moba_pool_decoder"


def rmsnorm(x, gain):
    xf = x.astype(jnp.float32)
    y = xf * lax.rsqrt(jnp.mean(xf * xf, axis=-1, keepdims=True) + RMS_EPS)
    return (y * gain.astype(jnp.float32)).astype(x.dtype)


def gla_chunkwise(q, k, v, log_f):
    bsz, nh, s, dk = q.shape
    dv = v.shape[-1]
    n = s // A_CHUNK

    def to_chunks(t):
        return t.reshape(bsz, nh, n, A_CHUNK, t.shape[-1]).transpose(2, 0, 1, 3, 4)

    causal = jnp.tril(jnp.ones((A_CHUNK, A_CHUNK), bool))[:, :, None]

    def step(state, xs):
        qc, kc, vc, gc = xs
        b = jnp.cumsum(gc, axis=-2)
        o_inter = jnp.einsum('bhtd,bhde->bhte', qc * jnp.exp(b), state)
        diff = b[:, :, :, None, :] - b[:, :, None, :, :]
        decay = jnp.where(causal, jnp.exp(jnp.where(causal, diff, 0.0)), 0.0)
        attn = jnp.einsum('bhtd,bhsd,bhtsd->bhts', qc, kc, decay)
        o_intra = jnp.einsum('bhts,bhse->bhte', attn, vc)
        b_last = b[:, :, -1:, :]
        new_state = (jnp.exp(b_last[:, :, 0, :, None]) * state
                     + jnp.einsum('bhsd,bhse->bhde', kc * jnp.exp(b_last - b), vc))
        return new_state, o_inter + o_intra

    state0 = jnp.zeros((bsz, nh, dk, dv), jnp.float32)
    _, out = lax.scan(step, state0, (to_chunks(q), to_chunks(k), to_chunks(v), to_chunks(log_f)))
    return out.transpose(1, 2, 0, 3, 4).reshape(bsz, nh, s, dv)


def hgrn2_mixer(h, w_in, lower_bound, head_norm, w_out):
    bsz, s, _ = h.shape
    proj = h @ w_in
    q, f, i, g = jnp.split(proj, 4, axis=-1)

    def heads(t, d):
        return t.reshape(bsz, s, A_HEADS, d).transpose(0, 2, 1, 3).astype(jnp.float32)

    q = jax.nn.silu(heads(q, A_EXPAND))
    f = heads(f, A_EXPAND)
    v = heads(i, A_HEAD_V)
    lb = lower_bound.reshape(1, A_HEADS, 1, A_EXPAND)
    log_f = jnp.logaddexp(jnp.log(lb), jnp.log1p(-lb) + jax.nn.log_sigmoid(f))
    k = (1.0 - lb) * jax.nn.sigmoid(-f)
    o = gla_chunkwise(q, k, v, log_f)
    o = rmsnorm(o, head_norm)
    o = o.transpose(0, 2, 1, 3).reshape(bsz, s, D_MODEL).astype(h.dtype)
    return (o * jax.nn.silu(g)) @ w_out


def t5_bucket(dist):
    n = jnp.maximum(dist, 0)
    max_exact = REL_BUCKETS // 2
    nf = jnp.maximum(n, 1).astype(jnp.float32)
    large = max_exact + (jnp.log(nf / max_exact) / math.log(REL_MAX_DISTANCE / max_exact)
                         * (REL_BUCKETS - max_exact)).astype(jnp.int32)
    large = jnp.minimum(large, REL_BUCKETS - 1)
    return jnp.where(n < max_exact, n, large)


def moba_attention(q, k, v, rel_table):
    bsz, nh, s, dh = q.shape
    n_blk = -(-s // B_BLOCK)
    pad = n_blk * B_BLOCK - s
    kb = jnp.pad(k, ((0, 0), (0, 0), (0, pad), (0, 0))).reshape(bsz, nh, n_blk, B_BLOCK, dh)
    vb = jnp.pad(v, ((0, 0), (0, 0), (0, pad), (0, 0))).reshape(bsz, nh, n_blk, B_BLOCK, dh)
    k_mean = jnp.mean(kb, axis=3)
    gate = jnp.einsum('bhtd,bhnd->bhtn', q, k_mean)
    q_blk = jnp.arange(s) // B_BLOCK
    past = jnp.arange(n_blk)[None, :] < q_blk[:, None]
    gate = jnp.where(past, gate, -jnp.inf)
    n_sel = min(B_TOPK, n_blk)
    _, sel = lax.top_k(gate, n_sel)

    qb = B_QUERY_BLOCK
    n_q = s // qb

    def by_qblock(t):
        return t.reshape(bsz, nh, n_q, qb, t.shape[-1]).transpose(0, 2, 1, 3, 4).reshape(bsz * n_q, nh, qb, t.shape[-1])

    b_ids = jnp.repeat(jnp.arange(bsz), n_q)
    qb_ids = jnp.tile(jnp.arange(n_q), bsz)
    table_hb = rel_table.T.astype(jnp.float32)
    scale = 1.0 / math.sqrt(dh)
    h3 = jnp.arange(nh)[:, None, None]
    h4 = jnp.arange(nh)[:, None, None, None]
    key_off = jnp.arange(B_BLOCK)

    def attend(args):
        qq, sq, b_id, qb_id = args
        kb_b = kb[b_id]
        vb_b = vb[b_id]
        k_sel = kb_b[h3, sq]
        v_sel = vb_b[h3, sq]
        own = (qb_id * qb) // B_BLOCK
        k_own = lax.dynamic_index_in_dim(kb_b, own, axis=1, keepdims=False)
        v_own = lax.dynamic_index_in_dim(vb_b, own, axis=1, keepdims=False)
        t = qb_id * qb + jnp.arange(qb)
        s_sel = jnp.einsum('hqd,hqjkd->hqjk', qq, k_sel) * scale
        dist_sel = t[None, :, None, None] - (sq[..., None] * B_BLOCK + key_off)
        ok_sel = (jnp.arange(n_sel)[None, :, None] < (t // B_BLOCK)[:, None, None])[None]
        s_sel = jnp.where(ok_sel, s_sel + table_hb[h4, t5_bucket(dist_sel)], -jnp.inf)
        s_own = jnp.einsum('hqd,hkd->hqk', qq, k_own) * scale
        dist_own = t[:, None] - (own * B_BLOCK + key_off)[None, :]
        s_own = jnp.where((dist_own >= 0)[None], s_own + table_hb[h3, t5_bucket(dist_own)], -jnp.inf)
        scores = jnp.concatenate([s_sel.reshape(nh, qb, n_sel * B_BLOCK), s_own], axis=-1)
        p = jax.nn.softmax(scores, axis=-1)
        p_sel = p[..., :n_sel * B_BLOCK].reshape(nh, qb, n_sel, B_BLOCK)
        p_own = p[..., n_sel * B_BLOCK:]
        return (jnp.einsum('hqjk,hqjkd->hqd', p_sel, v_sel)
                + jnp.einsum('hqk,hkd->hqd', p_own, v_own))

    out = lax.map(attend, (by_qblock(q), by_qblock(sel), b_ids, qb_ids))
    return out.reshape(bsz, n_q, nh, qb, dh).transpose(0, 2, 1, 3, 4).reshape(bsz, nh, s, dh)


def moba_mixer(h, w_qkv, w_out, rel_table):
    bsz, s, _ = h.shape
    q, k, v = jnp.split(h @ w_qkv, 3, axis=-1)

    def heads(t):
        return t.reshape(bsz, s, B_HEADS, B_HEAD_DIM).transpose(0, 2, 1, 3).astype(jnp.float32)

    o = moba_attention(heads(q), heads(k), heads(v), rel_table)
    o = o.transpose(0, 2, 1, 3).reshape(bsz, s, D_MODEL).astype(h.dtype)
    return o @ w_out


def pool_mixer(h, w_group, scale):
    bsz, s, _ = h.shape
    hg = h.astype(jnp.float32).reshape(bsz, s, C_GROUPS, C_GROUP_DIM)
    cs = jnp.cumsum(hg, axis=1)
    pos1 = jnp.arange(1, s + 1).astype(jnp.float32)
    pooled = []
    for g, w in enumerate(C_WINDOWS):
        cg = cs[:, :, g]
        shifted = jnp.pad(cg, ((0, 0), (w, 0), (0, 0)))[:, :s]
        count = jnp.minimum(pos1, float(w))[None, :, None]
        pooled.append((cg - shifted) / count)
    pooled = jnp.stack(pooled, axis=2)
    mixed = jnp.einsum('bsgc,gcd->bsgd', pooled - hg, w_group.astype(jnp.float32))
    return (mixed.reshape(bsz, s, D_MODEL) * scale.astype(jnp.float32)).astype(h.dtype)


def sqrelu_mlp(h, w1, w2):
    a = jax.nn.relu(h @ w1)
    return (a * a) @ w2


def setup_inputs(seed: int = 0) -> dict:
    key = jax.random.key(seed)
    ks = jax.random.split(key, 16)

    def nrm(k, shape, fan_in):
        return jax.random.normal(k, shape, jnp.float32) * (fan_in ** -0.5)

    def gain(k, shape, s=0.05):
        return 1.0 + s * jax.random.normal(k, shape, jnp.float32)

    return {
        'x': jax.random.normal(ks[0], (BATCH, SEQ, D_MODEL), jnp.float32),
        'norm_mix': gain(ks[1], (DEPTH, D_MODEL)),
        'norm_mlp': gain(ks[2], (DEPTH, D_MODEL)),
        'norm_final': gain(ks[3], (D_MODEL,)),
        'a_w_in': nrm(ks[4], (N_A_LAYERS, D_MODEL, 4 * D_MODEL), D_MODEL),
        'a_lower_bound': jax.random.normal(ks[5], (N_A_LAYERS, A_HEADS * A_EXPAND), jnp.float32),
        'a_head_norm': gain(ks[6], (N_A_LAYERS, A_HEAD_V)),
        'a_w_out': nrm(ks[7], (N_A_LAYERS, D_MODEL, D_MODEL), D_MODEL),
        'b_w_qkv': nrm(ks[8], (N_B_LAYERS, D_MODEL, 3 * D_MODEL), D_MODEL),
        'b_w_out': nrm(ks[9], (N_B_LAYERS, D_MODEL, D_MODEL), D_MODEL),
        'rel_bias': 0.3 * jax.random.normal(ks[10], (REL_BUCKETS, B_HEADS), jnp.float32),
        'c_w_group': nrm(ks[11], (N_C_LAYERS, C_GROUPS, C_GROUP_DIM, C_GROUP_DIM), C_GROUP_DIM),
        'c_scale': gain(ks[12], (N_C_LAYERS, D_MODEL), 0.1),
        'mlp_w1': nrm(ks[13], (DEPTH, D_MODEL, D_FF), D_MODEL),
        'mlp_w2': nrm(ks[14], (DEPTH, D_FF, D_MODEL), D_FF),
    }


def reference(x, norm_mix, norm_mlp, norm_final, a_w_in, a_lower_bound, a_head_norm,
              a_w_out, b_w_qkv, b_w_out, rel_bias, c_w_group, c_scale, mlp_w1, mlp_w2):
    lb_cum = jnp.cumsum(jax.nn.softmax(a_lower_bound.astype(jnp.float32), axis=0), axis=0)
    lower_bounds = lb_cum - lb_cum[0:1]
    for i in range(DEPTH):
        mixer = i % N_MIXERS
        j = i // N_MIXERS
        h = rmsnorm(x, norm_mix[i])
        if mixer == 0:
            y = hgrn2_mixer(h, a_w_in[j], lower_bounds[j], a_head_norm[j], a_w_out[j])
        elif mixer == 1:
            y = moba_mixer(h, b_w_qkv[j], b_w_out[j], rel_bias)
        else:
            y = pool_mixer(h, c_w_group[j], c_scale[j])
        x = x + y.astype(x.dtype)
        x = x + sqrelu_mlp(rmsnorm(x, norm_mlp[i]), mlp_w1[i], mlp_w2[i]).astype(x.dtype)
    return rmsnorm(x, norm_final)
```

```cpp
#include <hip/hip_runtime.h>
#include <hip/hip_cooperative_groups.h>
#include <cstdio>
#include <cstdint>
namespace cg = cooperative_groups;

#ifndef ONE_LAUNCH
#define ONE_LAUNCH 0
#endif

__device__ __forceinline__ int opaque_tid() { int t = threadIdx.x; asm volatile("" : "+v"(t)); return t; }
namespace pg8 {
#define PG8_LAS __attribute__((address_space(3)))
typedef unsigned short bf16_t;
typedef short bf16x8 __attribute__((ext_vector_type(8)));
typedef float f32x4 __attribute__((ext_vector_type(4)));
typedef unsigned u32x4 __attribute__((ext_vector_type(4)));
typedef unsigned u32x2 __attribute__((ext_vector_type(2)));
constexpr int BM = 256, BK = 64, HALF = 128, HTB = HALF * BK * 2  , STAGE_BYTES = 8 * HTB, NXCD = 8, WGM = 8;

__host__ __device__ __forceinline__ int lds_byte(int r, int c) { const int st = (r >> 4) * 2 + (c >> 5), rr = r & 15, cc = c & 31, ob = rr * 64 + cc * 2; return st * 1024 + (ob ^ (((ob >> 9) & 1) << 5)); }
__host__ __device__ __forceinline__ void stage_rc(int b, int& R, int& C) { const int st = b / 1024, sb = b % 1024, swz = sb ^ (((sb >> 9) & 1) << 5); R = (st >> 1) * 16 + swz / 64; C = (st & 1) * 32 + (swz % 64) / 2; }
__host__ __device__ __forceinline__ int perm32(int rho) { const int n = rho >> 4, i = rho & 15; return 8 * (i >> 2) + 4 * n + (i & 3); }

struct Unit { int pm, pn; };
struct Gemm { const bf16_t* A; const bf16_t* Bt; int M, N, K; size_t a_gs; };

struct StaticOrder {
    int nM, nN, nwg, G, c;
    __host__ __device__ void init(int M, int N, int G_, int c_) { nM = M / BM; nN = N / BM; nwg = nM * nN; G = G_; c = c_; }
    __host__ __device__ bool next(int i, Unit& u) const {
        const long L = (long)i * G + c; if (L >= nwg) return false;
        int wgid = (int)L; { const int q = nwg / NXCD, r = nwg % NXCD, xcd = wgid % NXCD, off = wgid / NXCD; wgid = (xcd < r ? xcd * (q + 1) : r * (q + 1) + (xcd - r) * q) + off; }
        const int nig = WGM * nN, gid = wgid / nig, fm = gid * WGM, gsz = (nM - fm) < WGM ? (nM - fm) : WGM;
        u.pm = fm + ((wgid % nig) % gsz); u.pn = (wgid % nig) / gsz; return true;
    }
    __device__ __forceinline__ void a_ready(const Unit&) const {}
    __device__ __forceinline__ void done(const Unit&) const {}
};

__device__ __forceinline__ unsigned cvt_pk_bf16(float lo, float hi) { unsigned r; asm volatile("v_cvt_pk_bf16_f32 %0, %1, %2" : "=v"(r) : "v"(lo), "v"(hi)); return r; }

constexpr float RMS_EPS = 1e-6f;
__device__ __forceinline__ float ssq_row(const float* part, int row) {
    const f32x4* p = (const f32x4*)(part + (size_t)row * 16);
    const f32x4 a = p[0], b = p[1], c = p[2], d = p[3];
    return (((a[0] + a[1]) + (a[2] + a[3])) + ((b[0] + b[1]) + (b[2] + b[3]))) + (((c[0] + c[1]) + (c[2] + c[3])) + ((d[0] + d[1]) + (d[2] + d[3])));
}
__device__ __forceinline__ float silu_f(float v) { return v / (1.f + __expf(-v)); }

struct EpiAct {
    static constexpr bool PERM = true, AFTER_DRAIN = false;
    bf16_t* O; int ldc; const float* ssq; int mode; const float* lb; float qscale;
    __device__ __forceinline__ void operator()(const f32x4 (&acc)[2][2][4][2], const Unit& u, int wr, int wc, int fr, int fq) const {
        const int row0 = u.pm * BM + wr * 64 + fr, col0 = u.pn * BM + wc * 32 + 8 * fq;
        const int sec = (u.pn * BM) >> 10;
        int act = 0; float sc = 1.f;
        if (mode == 0) act = (sec == 0 || sec == 3) ? 1 : (sec == 1 ? 2 : 0);
        else if (mode == 1) sc = (sec == 0) ? qscale : 1.f;
        else act = 3;
#pragma unroll
        for (int ai = 0; ai < 2; ++ai)
#pragma unroll
            for (int m = 0; m < 4; ++m) {
                const int row = row0 + ai * HALF + m * 16;
                const float rs = __builtin_amdgcn_rsqf(ssq_row(ssq, row) * (1.0f / 1024.0f) + RMS_EPS) * sc;
                bf16_t* rowp = O + (size_t)row * ldc + col0;
#pragma unroll
                for (int bj = 0; bj < 2; ++bj) {
                    f32x4 v[2] = {acc[ai][bj][m][0] * rs, acc[ai][bj][m][1] * rs};
#pragma unroll
                    for (int n = 0; n < 2; ++n) {
                        f32x4 lbv = (f32x4){0.f, 0.f, 0.f, 0.f};
                        if (act == 2) lbv = *(const f32x4*)(lb + (col0 - 1024) + bj * HALF + 4 * n);
#pragma unroll
                        for (int e = 0; e < 4; ++e) {
                            float x = v[n][e];
                            if (act == 1) x = silu_f(x);
                            else if (act == 2) { const float l = lbv[e]; x = __logf(l + (1.f - l) / (1.f + __expf(-x))); }
                            else if (act == 3) { x = fmaxf(x, 0.f); x = x * x; }
                            v[n][e] = x;
                        }
                    }
                    u32x4 w; w.x = cvt_pk_bf16(v[0][0], v[0][1]); w.y = cvt_pk_bf16(v[0][2], v[0][3]); w.z = cvt_pk_bf16(v[1][0], v[1][1]); w.w = cvt_pk_bf16(v[1][2], v[1][3]);
                    *(u32x4*)(rowp + bj * HALF) = w;
                }
                asm volatile("" ::: "memory");
            }
    }
};

struct EpiRes {
    static constexpr bool PERM = false, AFTER_DRAIN = false;
    const float* xold; float* xout; bf16_t* xb; float* ssq_next; const float* cscale;
    __device__ __forceinline__ void operator()(const f32x4 (&acc)[2][2][4][2], const Unit& u, int wr, int wc, int fr, int fq) const {
        const int row0 = u.pm * BM + wr * 64 + fr, col0 = u.pn * BM + wc * 32 + 4 * fq;
#pragma unroll
        for (int ai = 0; ai < 2; ++ai)
#pragma unroll
            for (int m = 0; m < 4; ++m) {
                const int row = row0 + ai * HALF + m * 16; const size_t off = (size_t)row * 1024 + col0;
                float s = 0.f;
#pragma unroll
                for (int bj = 0; bj < 2; ++bj)
#pragma unroll
                    for (int n = 0; n < 2; ++n) {
                        const f32x4 xo = *(const f32x4*)(xold + off + bj * HALF + n * 16);
                        f32x4 csv = (f32x4){1.f, 1.f, 1.f, 1.f}; if (cscale) csv = *(const f32x4*)(cscale + col0 + bj * HALF + n * 16);
                        const f32x4 o = xo + acc[ai][bj][m][n] * csv;
                        *(f32x4*)(xout + off + bj * HALF + n * 16) = o;
                        u32x2 w; w.x = cvt_pk_bf16(o[0], o[1]); w.y = cvt_pk_bf16(o[2], o[3]);
                        *(u32x2*)(xb + off + bj * HALF + n * 16) = w;
                        s += (o[0] * o[0] + o[1] * o[1]) + (o[2] * o[2] + o[3] * o[3]);
                    }
                s += __shfl_xor(s, 16); s += __shfl_xor(s, 32);
                if (fq == 0) ssq_next[(size_t)row * 16 + u.pn * 4 + wc] = s;
                asm volatile("" ::: "memory");
            }
    }
};

template <class Epi, class Sched, bool ALIGN_EPI = false, bool SP2 = false>
__device__ __forceinline__ void gemm_phase(PG8_LAS unsigned char* lds, const Gemm g, const Sched& S, const Epi& E) {
    const int tid = opaque_tid(), wid = __builtin_amdgcn_readfirstlane(tid >> 6), lane = tid & 63, wr = wid >> 2, wc = wid & 3, fr = lane & 15, fq = lane >> 4;
    const int K = g.K, nt = K / BK;
    unsigned voffA[2], voffB[2];
#pragma unroll
    for (int i = 0; i < 2; ++i) { int R, C; stage_rc(tid * 16 + i * 8192, R, C); const int Rb = Epi::PERM ? ((R & ~31) + perm32(R & 31)) : R;
        voffA[i] = (unsigned)(R * K + C) * 2u; voffB[i] = (unsigned)(Rb * K + C) * 2u; }
    const size_t kstep = (size_t)(BK * 2);
    const size_t hstep = (size_t)HALF * K * 2;
    const size_t tstep = 2 * hstep;
    const unsigned ldsw = (unsigned)wid * 1024u;
    const int aoff = lds_byte(wr * 64 + fr, fq * 8), boff = lds_byte(wc * 32 + fr, fq * 8);
#define PG8_SA(b, h) (((b) * 2 + (h)) * HTB)
#define PG8_SB(b, h) ((4 + (b) * 2 + (h)) * HTB)
#define PG8_STAGE(bufoff, gbase, voff) do { _Pragma("unroll") for (int _i = 0; _i < 2; ++_i) \
        __builtin_amdgcn_global_load_lds((const unsigned*)((const char*)(gbase) + (voff)[_i]), (PG8_LAS unsigned*)(lds + (bufoff) + ldsw + _i * 8192), 16, 0, 0); } while (0)
#define PG8_LDA(dst, b, h) do { _Pragma("unroll") for (int m = 0; m < 4; ++m) _Pragma("unroll") for (int k = 0; k < 2; ++k) dst[m][k] = *(const PG8_LAS bf16x8*)(lds + PG8_SA(b, h) + aoff + m * 2048 + k * 1024); } while (0)
#define PG8_LDB(dst, b, h) do { _Pragma("unroll") for (int n = 0; n < 2; ++n) _Pragma("unroll") for (int k = 0; k < 2; ++k) dst[n][k] = *(const PG8_LAS bf16x8*)(lds + PG8_SB(b, h) + boff + n * 2048 + k * 1024); } while (0)
#define PG8_MMA(ai, bj, At, Bt) do { __builtin_amdgcn_s_setprio(1); _Pragma("unroll") for (int m = 0; m < 4; ++m) _Pragma("unroll") for (int n = 0; n < 2; ++n) _Pragma("unroll") for (int k = 0; k < 2; ++k) \
        acc[ai][bj][m][n] = __builtin_amdgcn_mfma_f32_16x16x32_bf16(Bt[n][k], At[m][k], acc[ai][bj][m][n], 0, 0, 0); __builtin_amdgcn_s_setprio(0); } while (0)
#define PG8_WAIT_V(n) asm volatile("s_waitcnt vmcnt(" #n ")" ::: "memory")
#define PG8_WAIT_L(n) asm volatile("s_waitcnt lgkmcnt(" #n ")" ::: "memory")
#define PG8_BAR __builtin_amdgcn_s_barrier()
#define PG8_SCHED __builtin_amdgcn_sched_barrier(0)
    Unit cur, nxt; int ui = 0;
    if (!S.next(0, cur)) return;
    f32x4 acc[2][2][4][2];
#pragma unroll
    for (int a = 0; a < 2; ++a)
#pragma unroll
        for (int b = 0; b < 2; ++b)
#pragma unroll
            for (int m = 0; m < 4; ++m)
#pragma unroll
                for (int n = 0; n < 2; ++n) acc[a][b][m][n] = (f32x4){0.f, 0.f, 0.f, 0.f};
    bf16x8 At[4][2], B0[2][2], B1[2][2];
    const char* cA = (const char*)g.A + (size_t)cur.pm * tstep + (size_t)cur.pn * g.a_gs; const char* cB = (const char*)g.Bt + (size_t)cur.pn * tstep;
    S.a_ready(cur);
    if constexpr (SP2) {
        PG8_STAGE(PG8_SB(0, 0), cB, voffB); PG8_STAGE(PG8_SB(0, 1), cB + hstep, voffB); PG8_STAGE(PG8_SA(0, 0), cA, voffA); PG8_STAGE(PG8_SA(0, 1), cA + hstep, voffA);
        if (wr == 1) PG8_BAR;
        PG8_WAIT_V(2); PG8_BAR;
        PG8_STAGE(PG8_SB(1, 0), cB + kstep, voffB); PG8_STAGE(PG8_SA(1, 0), cA + kstep, voffA); PG8_STAGE(PG8_SB(1, 1), cB + hstep + kstep, voffB);
        PG8_WAIT_V(6); PG8_BAR;
    } else {
        PG8_STAGE(PG8_SB(0, 0), cB, voffB); PG8_STAGE(PG8_SA(0, 0), cA, voffA); PG8_STAGE(PG8_SB(0, 1), cB + hstep, voffB); PG8_STAGE(PG8_SA(0, 1), cA + hstep, voffA);
        if (wr == 1) PG8_BAR;
        PG8_WAIT_V(4); PG8_BAR;
        PG8_STAGE(PG8_SB(1, 0), cB + kstep, voffB); PG8_STAGE(PG8_SA(1, 0), cA + kstep, voffA); PG8_STAGE(PG8_SB(1, 1), cB + hstep + kstep, voffB);
        PG8_WAIT_V(6); PG8_BAR;
    }
    for (;;) {
        const bool has_next = S.next(ui + 1, nxt);
        const char* nA = has_next ? (const char*)g.A + (size_t)nxt.pm * tstep + (size_t)nxt.pn * g.a_gs : cA; const char* nB = has_next ? (const char*)g.Bt + (size_t)nxt.pn * tstep : cB;
        for (int t = 0; t < nt; t += 2) {
            const bool last = (t == nt - 2);
            const char* a1 = cA + (size_t)(t + 1) * kstep;
            const char* a2 = last ? nA : cA + (size_t)(t + 2) * kstep; const char* b2 = last ? nB : cB + (size_t)(t + 2) * kstep;
            const char* a3 = a2 + kstep; const char* b3 = b2 + kstep;
            if (last && has_next) S.a_ready(nxt);
            if constexpr (SP2) {
            PG8_LDB(B0, 0, 0); PG8_LDB(B1, 0, 1); PG8_SCHED; PG8_LDA(At, 0, 0); PG8_STAGE(PG8_SA(1, 1), a1 + hstep, voffA);
            PG8_WAIT_V(8); PG8_WAIT_L(0); PG8_BAR; PG8_MMA(0, 0, At, B0); PG8_MMA(0, 1, At, B1); PG8_BAR; PG8_SCHED;
            PG8_LDA(At, 0, 1); PG8_STAGE(PG8_SB(0, 0), b2, voffB); PG8_STAGE(PG8_SB(0, 1), b2 + hstep, voffB); PG8_STAGE(PG8_SA(0, 0), a2, voffA);
            PG8_WAIT_V(8); PG8_WAIT_L(0); PG8_BAR; PG8_MMA(1, 0, At, B0); PG8_MMA(1, 1, At, B1); PG8_BAR; PG8_SCHED;
            PG8_LDB(B0, 1, 0); PG8_LDB(B1, 1, 1); PG8_SCHED; PG8_LDA(At, 1, 0); PG8_STAGE(PG8_SA(0, 1), a2 + hstep, voffA);
            PG8_WAIT_V(8); PG8_WAIT_L(0); PG8_BAR; PG8_MMA(0, 0, At, B0); PG8_MMA(0, 1, At, B1); PG8_BAR; PG8_SCHED;
            PG8_LDA(At, 1, 1); PG8_STAGE(PG8_SB(1, 0), b3, voffB); PG8_STAGE(PG8_SB(1, 1), b3 + hstep, voffB); PG8_STAGE(PG8_SA(1, 0), a3, voffA);
            PG8_WAIT_V(8); PG8_WAIT_L(0); PG8_BAR; PG8_MMA(1, 0, At, B0); PG8_MMA(1, 1, At, B1); PG8_BAR; PG8_SCHED;
            } else {
            PG8_LDB(B0, 0, 0); PG8_SCHED; PG8_LDA(At, 0, 0); PG8_STAGE(PG8_SA(1, 1), a1 + hstep, voffA);
            PG8_WAIT_L(8); PG8_BAR; PG8_WAIT_L(0); PG8_MMA(0, 0, At, B0); PG8_BAR; PG8_SCHED;
            PG8_LDB(B1, 0, 1); PG8_STAGE(PG8_SB(0, 0), b2, voffB);
            PG8_BAR; PG8_WAIT_L(0); PG8_MMA(0, 1, At, B1); PG8_BAR;
            PG8_LDA(At, 0, 1); PG8_STAGE(PG8_SA(0, 0), a2, voffA);
            PG8_BAR; PG8_WAIT_L(0); PG8_MMA(1, 0, At, B0); PG8_BAR; PG8_SCHED;
            PG8_STAGE(PG8_SB(0, 1), b2 + hstep, voffB);
            PG8_WAIT_V(6); PG8_BAR; PG8_MMA(1, 1, At, B1); PG8_BAR;
            PG8_LDB(B0, 1, 0); PG8_SCHED; PG8_LDA(At, 1, 0); PG8_STAGE(PG8_SA(0, 1), a2 + hstep, voffA);
            PG8_WAIT_L(8); PG8_BAR; PG8_WAIT_L(0); PG8_MMA(0, 0, At, B0); PG8_BAR; PG8_SCHED;
            PG8_LDB(B1, 1, 1); PG8_STAGE(PG8_SB(1, 0), b3, voffB);
            PG8_BAR; PG8_WAIT_L(0); PG8_MMA(0, 1, At, B1); PG8_BAR;
            PG8_LDA(At, 1, 1); PG8_STAGE(PG8_SA(1, 0), a3, voffA);
            PG8_BAR; PG8_WAIT_L(0); PG8_MMA(1, 0, At, B0); PG8_BAR; PG8_SCHED;
            PG8_STAGE(PG8_SB(1, 1), b3 + hstep, voffB);
            PG8_WAIT_V(6); PG8_BAR; PG8_MMA(1, 1, At, B1); PG8_BAR;
            }
        }
        if constexpr (ALIGN_EPI) { if (wr == 0) PG8_BAR; }
        if constexpr (!Epi::AFTER_DRAIN) { E(acc, cur, wr, wc, fr, fq); S.done(cur); }
        if (!has_next) break;
#pragma unroll
        for (int a = 0; a < 2; ++a)
#pragma unroll
            for (int b = 0; b < 2; ++b)
#pragma unroll
                for (int m = 0; m < 4; ++m)
#pragma unroll
                    for (int n = 0; n < 2; ++n) acc[a][b][m][n] = (f32x4){0.f, 0.f, 0.f, 0.f};
        cur = nxt; cA = nA; cB = nB; ++ui;
        if constexpr (ALIGN_EPI) { if (wr == 1) PG8_BAR; }
    }
    PG8_WAIT_V(0);
    if constexpr (!ALIGN_EPI) { if (wr == 0) PG8_BAR; }
    PG8_BAR;
    if constexpr (Epi::AFTER_DRAIN) { E.fused(acc, cur, wr, wc, fr, fq, lds, wid, lane); S.done(cur); }
#undef PG8_SA
#undef PG8_SB
#undef PG8_STAGE
#undef PG8_LDA
#undef PG8_LDB
#undef PG8_MMA
#undef PG8_WAIT_V
#undef PG8_WAIT_L
#undef PG8_BAR
#undef PG8_SCHED
}
}

#define LAS __attribute__((address_space(3)))
typedef unsigned short bf16_t;
typedef short bf16x8 __attribute__((ext_vector_type(8)));
typedef short s16x4 __attribute__((ext_vector_type(4)));
typedef float f32x4 __attribute__((ext_vector_type(4)));
typedef float f32x2 __attribute__((ext_vector_type(2)));
typedef unsigned u32x4 __attribute__((ext_vector_type(4)));
typedef unsigned u32x2 __attribute__((ext_vector_type(2)));

constexpr int NB = 16, SEQ = 2048, DM = 1024, MT = NB * SEQ, FF = 4096, NH = 8, HD = 128, DEPTH = 4;
constexpr float EPS = 1e-6f;
constexpr size_t MiB = 1u << 20;
constexpr size_t WS_SSQ = 0;
constexpr size_t WS_KMEAN = 2 * MiB;
constexpr size_t WS_BIAST = 2 * MiB + 768 * 1024;
constexpr size_t WS_LB = 3 * MiB;
constexpr size_t WS_AWIN = 4 * MiB, WS_AWOUT = 20 * MiB, WS_BQKV = 24 * MiB, WS_BOUT = 30 * MiB, WS_CW = 32 * MiB, WS_W1 = 33 * MiB, WS_W2 = 65 * MiB;
constexpr size_t WS_XB = 98 * MiB, WS_O2 = 162 * MiB, WS_BIG = 226 * MiB, WS_SSQ1 = 482 * MiB, WS_END = 484 * MiB;
constexpr int LDS_BYTES = 147456;
constexpr int NTHREADS = 512;

__device__ __forceinline__ unsigned f2bf(float f) { unsigned u = __builtin_bit_cast(unsigned, f); return (u + 0x7fffu + ((u >> 16) & 1u)) >> 16; }
typedef __bf16 bf16x2_t __attribute__((ext_vector_type(2)));
__device__ __forceinline__ unsigned pk2(float lo, float hi) { f32x2 v = {lo, hi}; bf16x2_t b = __builtin_convertvector(v, bf16x2_t); return __builtin_bit_cast(unsigned, b); }
__device__ __forceinline__ float bf2f(unsigned h) { return __builtin_bit_cast(float, (h & 0xffffu) << 16); }
__device__ __forceinline__ float wave_sum(float v) {
#pragma unroll
    for (int o = 1; o < 64; o <<= 1) v += __shfl_xor(v, o);
    return v;
}
#define MFMA16(a, b, c) __builtin_amdgcn_mfma_f32_16x16x32_bf16((a), (b), (c), 0, 0, 0)
#define LDS_WAIT() asm volatile("s_waitcnt lgkmcnt(0)" ::: "memory")

__device__ __forceinline__ void p0_transpose_item(const float* W, int K, int N, bf16_t* WT, int row_off, const float* gain, LAS float* scr, int item, int lane) {
    const int nblk = N / 32, kb = item / nblk, nb = item % nblk, k0 = 64 * kb, n0 = 32 * nb;
#pragma unroll 8
    for (int i = 0; i < 32; ++i) { const int kk = 2 * i + (lane >> 5); const float gk = gain ? gain[k0 + kk] : 1.f; scr[kk * 33 + (lane & 31)] = W[(size_t)(k0 + kk) * N + n0 + (lane & 31)] * gk; }
    LDS_WAIT(); asm volatile("" ::: "memory");
    const int c = lane & 7;
#pragma unroll
    for (int j = 0; j < 4; ++j) { const int n = (lane >> 3) + 8 * j; const LAS float* s = scr + (8 * c) * 33 + n;
        u32x4 o; o.x = pk2(s[0 * 33], s[1 * 33]); o.y = pk2(s[2 * 33], s[3 * 33]); o.z = pk2(s[4 * 33], s[5 * 33]); o.w = pk2(s[6 * 33], s[7 * 33]);
        *(u32x4*)(WT + (size_t)(row_off + n0 + n) * K + k0 + 8 * c) = o; }
    LDS_WAIT(); asm volatile("" ::: "memory");
}

struct Args {
    const float* in[15]; float* out; unsigned char* ws; int ph_lo, ph_hi;
};

__device__ __forceinline__ int t5_bucket(int n) {
    if (n < 16) return n;
    const float v = (__log2f((float)n * (1.0f / 16.0f)) * 16.0f) / 6.0f;
    int l = 16 + (int)v; return l < 31 ? l : 31;
}

__device__ __forceinline__ void p0_phase(const Args& a, LAS unsigned char* lds, int G, int wg) {
    const int tid = opaque_tid(), lane = tid & 63, wave = tid >> 6;
    unsigned char* ws = a.ws;
    const float* norm_mix = a.in[1]; const float* norm_mlp = a.in[2];
    LAS float* scr = (LAS float*)(lds + wave * 16384);
    const int gw = wg * 8 + wave, NGW = G * 8;
    constexpr int I_AIN = (DM / 64) * (4096 / 32), I_SQ = (DM / 64) * (DM / 32), I_QKV = (DM / 64) * (3072 / 32), I_CW = (256 / 64) * (256 / 32), I_W1 = (DM / 64) * (FF / 32), I_W2 = (FF / 64) * (DM / 32);
    constexpr int NITEMS = 2 * I_AIN + 2 * I_SQ + I_QKV + I_SQ + 4 * I_CW + 4 * I_W1 + 4 * I_W2;
    for (int it = gw; it < NITEMS; it += NGW) {
        int r = it;
        if (r < 2 * I_AIN) { const int j = r / I_AIN; r -= j * I_AIN;
            p0_transpose_item(a.in[4] + (size_t)j * DM * 4096, DM, 4096, (bf16_t*)(ws + WS_AWIN) + (size_t)j * 4096 * DM, 0, norm_mix + (3 * j) * DM, scr, r, lane); continue; } r -= 2 * I_AIN;
        if (r < 2 * I_SQ) { const int j = r / I_SQ; r -= j * I_SQ;
            p0_transpose_item(a.in[7] + (size_t)j * DM * DM, DM, DM, (bf16_t*)(ws + WS_AWOUT) + (size_t)j * DM * DM, 0, nullptr, scr, r, lane); continue; } r -= 2 * I_SQ;
        if (r < I_QKV) { p0_transpose_item(a.in[8], DM, 3072, (bf16_t*)(ws + WS_BQKV), 0, norm_mix + 1 * DM, scr, r, lane); continue; } r -= I_QKV;
        if (r < I_SQ) { p0_transpose_item(a.in[9], DM, DM, (bf16_t*)(ws + WS_BOUT), 0, nullptr, scr, r, lane); continue; } r -= I_SQ;
        if (r < 4 * I_CW) { const int g = r / I_CW; r -= g * I_CW;
            p0_transpose_item(a.in[11] + (size_t)g * 256 * 256, 256, 256, (bf16_t*)(ws + WS_CW), g * 256, nullptr, scr, r, lane); continue; } r -= 4 * I_CW;
        if (r < 4 * I_W1) { const int j = r / I_W1; r -= j * I_W1;
            p0_transpose_item(a.in[13] + (size_t)j * DM * FF, DM, FF, (bf16_t*)(ws + WS_W1) + (size_t)j * FF * DM, 0, norm_mlp + j * DM, scr, r, lane); continue; } r -= 4 * I_W1;
        { const int j = r / I_W2; r -= j * I_W2;
            p0_transpose_item(a.in[14] + (size_t)j * FF * DM, FF, DM, (bf16_t*)(ws + WS_W2) + (size_t)j * DM * FF, 0, nullptr, scr, r, lane); }
    }
    const float* x = a.in[0]; float* ssq = (float*)(ws + WS_SSQ); bf16_t* xb = (bf16_t*)(ws + WS_XB);
    for (int m = gw; m < MT; m += NGW) {
        const f32x4* xr = (const f32x4*)(x + (size_t)m * DM) + lane; float s = 0.f;
        unsigned long long* o8 = (unsigned long long*)(xb + (size_t)m * DM) + lane;
#pragma unroll
        for (int j = 0; j < 4; ++j) { const f32x4 v = xr[64 * j]; s += (v.x * v.x + v.y * v.y) + (v.z * v.z + v.w * v.w);
            o8[64 * j] = (unsigned long long)pk2(v.x, v.y) | ((unsigned long long)pk2(v.z, v.w) << 32); }
        s = wave_sum(s);
        if (lane < 16) ssq[(size_t)m * 16 + lane] = (lane == 0) ? s : 0.f;
    }
    const int gt = wg * NTHREADS + tid, NGT = G * NTHREADS;
    float* biasT = (float*)(ws + WS_BIAST); const float* rel = a.in[10];
    for (int i = gt; i < NH * 2048; i += NGT) { const int h = i >> 11, dist = i & 2047; biasT[i] = rel[t5_bucket(dist) * NH + h] * 1.4426950408889634f; }
    float* lb = (float*)(ws + WS_LB); const float* alb = a.in[5];
    for (int i = gt; i < 1024; i += NGT) { lb[i] = 0.f; lb[1024 + i] = 1.f / (1.f + __expf(alb[i] - alb[1024 + i])); }
}

__device__ __forceinline__ void kmean_phase(const bf16_t* QKV, float* kmean, int G, int wg) {
    const int tid = opaque_tid();
    for (int u = wg; u < NB * 8; u += G) {
        const int b = u >> 3, n = u & 7;
        const bf16_t* kp = QKV + ((size_t)b * SEQ + n * 256) * 3072 + 1024 + 2 * tid;
        float s0 = 0.f, s1 = 0.f;
#pragma unroll 8
        for (int r = 0; r < 256; ++r) { const unsigned w = *(const unsigned*)(kp + (size_t)r * 3072); s0 += bf2f(w); s1 += bf2f(w >> 16); }
        const int c = 2 * tid, h = c >> 7, d = c & 127;
        float* o = kmean + ((size_t)((b * 8 + h) * 8 + n)) * 128 + d;
        o[0] = s0 * (1.f / 256.f); o[1] = s1 * (1.f / 256.f);
    }
}

__device__ __forceinline__ void attn_phase(LAS unsigned char* lds, const bf16_t* QKV, const float* kmean, const float* biasT, bf16_t* O, int G, int wg) {
    const int tid = opaque_tid(), lane = tid & 63, wid = tid >> 6, fr = lane & 15, fq = lane >> 4;
    constexpr int KS_OFF = 0, KS_STR = 272, VT_OFF = 64 * 272, VT_STR = 144, BT_OFF = VT_OFF + 128 * 144;
    LAS float* BT = (LAS float*)(lds + BT_OFF);
    for (int u = wg; u < 2048; u += G) {
        const int qb = 15 - (u >> 7), bh = u & 127, b = bh >> 3, h = bh & 7, ob = qb >> 1;
        const size_t rowbase = (size_t)b * SEQ;
        __syncthreads();
        for (int i = tid; i < 2048; i += NTHREADS) BT[i] = biasT[h * 2048 + i];
        const int tq = qb * 128 + wid * 16 + fr;
        const bf16_t* qp = QKV + (rowbase + tq) * 3072 + h * 128 + fq * 8;
        bf16x8 qf[4];
#pragma unroll
        for (int ks = 0; ks < 4; ++ks) qf[ks] = *(const bf16x8*)(qp + ks * 32);
        unsigned selmask = 0u;
        if (ob <= 3) selmask = (1u << ob) - 1u;
        else {
            float gate[7];
#pragma unroll
            for (int n = 0; n < 7; ++n) {
                float p = 0.f;
                if (n < ob) {
                    const float* km = kmean + ((size_t)(bh * 8 + n)) * 128 + fq * 8;
#pragma unroll
                    for (int ks = 0; ks < 4; ++ks) {
                        const f32x4 k0 = *(const f32x4*)(km + ks * 32), k1 = *(const f32x4*)(km + ks * 32 + 4);
#pragma unroll
                        for (int j = 0; j < 4; ++j) { p += bf2f((unsigned short)qf[ks][j]) * k0[j]; p += bf2f((unsigned short)qf[ks][4 + j]) * k1[j]; }
                    }
                }
                p += __shfl_xor(p, 16); p += __shfl_xor(p, 32);
                gate[n] = (n < ob) ? p : -INFINITY;
            }
#pragma unroll
            for (int r = 0; r < 3; ++r) {
                float best = -INFINITY; int bi = 0;
#pragma unroll
                for (int n = 0; n < 7; ++n) { const bool free_ = !((selmask >> n) & 1u); if (free_ && gate[n] > best) { best = gate[n]; bi = n; } }
                selmask |= 1u << bi;
            }
        }
        const int nOwn = (qb & 1) ? 4 : 2, nTiles = nOwn + ob * 4;
        float m_run = -1e30f, l_run = 0.f;
        f32x4 oacc[8];
#pragma unroll
        for (int e = 0; e < 8; ++e) oacc[e] = (f32x4){0.f, 0.f, 0.f, 0.f};
        for (int ti = 0; ti < nTiles; ++ti) {
            const bool own = ti < nOwn; const int r_ = ti - nOwn; const int blk = own ? ob : (r_ >> 2), kt = own ? ti : (r_ & 3);
            const int key0 = blk * 256 + kt * 64;
            __syncthreads();
            { const bf16_t* kp = QKV + (rowbase + key0 + (tid >> 3)) * 3072 + 1024 + h * 128 + (tid & 7) * 16;
              const u32x4 a0 = *(const u32x4*)kp, a1 = *(const u32x4*)(kp + 8);
              LAS unsigned char* dst = lds + KS_OFF + (tid >> 3) * KS_STR + (tid & 7) * 32;
              *(LAS u32x4*)dst = a0; *(LAS u32x4*)(dst + 16) = a1; }
            { const bf16_t* vp = QKV + (rowbase + key0 + (tid & 63)) * 3072 + 2048 + h * 128 + (tid >> 6) * 16;
              const u32x4 a0 = *(const u32x4*)vp, a1 = *(const u32x4*)(vp + 8);
              LAS unsigned char* dst = lds + VT_OFF + ((tid >> 6) * 16) * VT_STR + (tid & 63) * 2;
#pragma unroll
              for (int j = 0; j < 8; ++j) { *(LAS bf16_t*)(dst + j * VT_STR) = (bf16_t)(a0[j >> 1] >> (16 * (j & 1))); *(LAS bf16_t*)(dst + (8 + j) * VT_STR) = (bf16_t)(a1[j >> 1] >> (16 * (j & 1))); } }
            __syncthreads();
            f32x4 sc[4];
#pragma unroll
            for (int st = 0; st < 4; ++st) { sc[st] = (f32x4){0.f, 0.f, 0.f, 0.f};
#pragma unroll
                for (int ks = 0; ks < 4; ++ks) { const bf16x8 af = *(const LAS bf16x8*)(lds + KS_OFF + (st * 16 + fr) * KS_STR + (ks * 32 + fq * 8) * 2); sc[st] = MFMA16(af, qf[ks], sc[st]); } }
            const bool selok = (selmask >> blk) & 1u;
            float mx = -1e30f;
#pragma unroll
            for (int st = 0; st < 4; ++st)
#pragma unroll
                for (int j = 0; j < 4; ++j) { const int dist = tq - (key0 + st * 16 + fq * 4 + j); const bool ok = own ? (dist >= 0) : selok;
                    float s = sc[st][j] + BT[dist < 0 ? 0 : dist]; s = ok ? s : -1e30f; sc[st][j] = s; mx = fmaxf(mx, s); }
            mx = fmaxf(mx, __shfl_xor(mx, 16)); mx = fmaxf(mx, __shfl_xor(mx, 32));
            const float m_new = fmaxf(m_run, mx), alpha = exp2f(m_run - m_new); m_run = m_new;
            float ps = 0.f;
#pragma unroll
            for (int st = 0; st < 4; ++st)
#pragma unroll
                for (int j = 0; j < 4; ++j) { const float p = exp2f(sc[st][j] - m_new); sc[st][j] = p; ps += p; }
            l_run = l_run * alpha + ps;
#pragma unroll
            for (int e = 0; e < 8; ++e) oacc[e] = oacc[e] * alpha;
            bf16x8 pf[2];
#pragma unroll
            for (int i = 0; i < 2; ++i) { u32x4 w; w.x = pk2(sc[2 * i][0], sc[2 * i][1]); w.y = pk2(sc[2 * i][2], sc[2 * i][3]); w.z = pk2(sc[2 * i + 1][0], sc[2 * i + 1][1]); w.w = pk2(sc[2 * i + 1][2], sc[2 * i + 1][3]); pf[i] = __builtin_bit_cast(bf16x8, w); }
#pragma unroll
            for (int e = 0; e < 8; ++e)
#pragma unroll
                for (int i = 0; i < 2; ++i) {
                    const LAS unsigned char* vr = lds + VT_OFF + (e * 16 + fr) * VT_STR + (32 * i + fq * 4) * 2;
                    const s16x4 lo = *(const LAS s16x4*)vr, hi = *(const LAS s16x4*)(vr + 32);
                    const bf16x8 af = __builtin_shufflevector(lo, hi, 0, 1, 2, 3, 4, 5, 6, 7);
                    oacc[e] = MFMA16(af, pf[i], oacc[e]);
                }
        }
        float l = l_run; l += __shfl_xor(l, 16); l += __shfl_xor(l, 32);
        const float inv = 1.f / l;
        bf16_t* op = O + (rowbase + tq) * 1024 + h * 128 + fq * 4;
#pragma unroll
        for (int e = 0; e < 8; ++e) { u32x2 w; w.x = pk2(oacc[e][0] * inv, oacc[e][1] * inv); w.y = pk2(oacc[e][2] * inv, oacc[e][3] * inv); *(u32x2*)(op + e * 16) = w; }
    }
}

__device__ __forceinline__ void gla_phase(LAS unsigned char* lds, const bf16_t* P, const float* hn, bf16_t* O, int G, int wg) {
    const int tid = opaque_tid(), lane = tid & 63, wid = tid >> 6, fr = lane & 15, fq = lane >> 4;
    constexpr int QT = 0, KT = 17408, QH = 34816, KHT = 52224, VT = 70656, AM = 89088, ST = 98304, PART = 133120, BLAST = 135168, SSQX = 135680;
    constexpr int RS = 272, TS = 144;
    const int d = tid & 127, tq = tid >> 7;
    for (int unit = wg; unit < NB * NH; unit += G) {
        const int b = unit >> 3, h = unit & 7;
        __syncthreads();
        for (int i = tid; i < 34816 / 4; i += NTHREADS) ((LAS unsigned*)(lds + ST))[i] = 0u;
        f32x4 sacc[8];
#pragma unroll
        for (int e = 0; e < 8; ++e) sacc[e] = (f32x4){0.f, 0.f, 0.f, 0.f};
        const bf16_t* pbase = P + ((size_t)b * SEQ) * 4096 + h * 128;
        unsigned short rq[16], rl[16], rv[16];
        { const bf16_t* pp = pbase + (size_t)(tq * 16) * 4096 + d;
#pragma unroll
          for (int i = 0; i < 16; ++i) { rq[i] = pp[(size_t)i * 4096]; rl[i] = pp[(size_t)i * 4096 + 1024]; rv[i] = pp[(size_t)i * 4096 + 2048]; } }
        for (int c = 0; c < 32; ++c) {
            float q[16], lf[16], bl[16]; unsigned short vv[16];
            float run = 0.f;
#pragma unroll
            for (int i = 0; i < 16; ++i) { q[i] = bf2f(rq[i]); lf[i] = bf2f(rl[i]); vv[i] = rv[i]; run += lf[i]; bl[i] = run; }
            if (c < 31) { const bf16_t* pp = pbase + (size_t)((c + 1) * 64 + tq * 16) * 4096 + d;
#pragma unroll
                for (int i = 0; i < 16; ++i) { rq[i] = pp[(size_t)i * 4096]; rl[i] = pp[(size_t)i * 4096 + 1024]; rv[i] = pp[(size_t)i * 4096 + 2048]; } }
            ((LAS float*)(lds + PART))[tq * 128 + d] = run;
            __syncthreads();
            const float p0 = ((LAS float*)(lds + PART))[d], p1 = ((LAS float*)(lds + PART))[128 + d], p2 = ((LAS float*)(lds + PART))[256 + d], p3 = ((LAS float*)(lds + PART))[384 + d];
            const float off = (tq > 0 ? p0 : 0.f) + (tq > 1 ? p1 : 0.f) + (tq > 2 ? p2 : 0.f);
            const float bm = p0 + p1, blast = (p0 + p1) + (p2 + p3);
            if (tq == 0) ((LAS float*)(lds + BLAST))[d] = __expf(blast);
            unsigned kh[8], vt[8];
#pragma unroll
            for (int i = 0; i < 16; i += 2) {
                float khv[2];
#pragma unroll
                for (int z = 0; z < 2; ++z) {
                    const int ii = i + z, t = tq * 16 + ii; const float bt = bl[ii] + off;
                    const float kv = 1.f - __expf(lf[ii]);
                    const float e1 = __expf(fminf(bt - bm, 60.f)), e2 = __expf(fminf(bm - bt, 60.f)), e3 = __expf(bt), e4 = __expf(blast - bt);
                    *(LAS bf16_t*)(lds + QT + t * RS + d * 2) = (bf16_t)f2bf(q[ii] * e1);
                    *(LAS bf16_t*)(lds + KT + t * RS + d * 2) = (bf16_t)f2bf(kv * e2);
                    *(LAS bf16_t*)(lds + QH + t * RS + d * 2) = (bf16_t)f2bf(q[ii] * e3);
                    khv[z] = kv * e4;
                }
                kh[i >> 1] = pk2(khv[0], khv[1]); vt[i >> 1] = (unsigned)vv[i] | ((unsigned)vv[i + 1] << 16);
            }
            { LAS unsigned char* dk = lds + KHT + d * TS + tq * 32; LAS unsigned char* dv = lds + VT + d * TS + tq * 32;
              *(LAS u32x4*)dk = (u32x4){kh[0], kh[1], kh[2], kh[3]}; *(LAS u32x4*)(dk + 16) = (u32x4){kh[4], kh[5], kh[6], kh[7]};
              *(LAS u32x4*)dv = (u32x4){vt[0], vt[1], vt[2], vt[3]}; *(LAS u32x4*)(dv + 16) = (u32x4){vt[4], vt[5], vt[6], vt[7]}; }
            __syncthreads();
            { const int st = wid & 3;
#pragma unroll
              for (int z = 0; z < 2; ++z) { const int tt = (wid >> 2) * 2 + z; f32x4 acc = (f32x4){0.f, 0.f, 0.f, 0.f};
                if (tt >= st) {
#pragma unroll
                    for (int ks = 0; ks < 4; ++ks) { const bf16x8 af = *(const LAS bf16x8*)(lds + KT + (st * 16 + fr) * RS + (ks * 32 + fq * 8) * 2), bq = *(const LAS bf16x8*)(lds + QT + (tt * 16 + fr) * RS + (ks * 32 + fq * 8) * 2); acc = MFMA16(af, bq, acc); }
                }
                const int t = tt * 16 + fr, s0 = st * 16 + fq * 4;
                u32x2 w; w.x = pk2(t >= s0 ? acc[0] : 0.f, t >= s0 + 1 ? acc[1] : 0.f); w.y = pk2(t >= s0 + 2 ? acc[2] : 0.f, t >= s0 + 3 ? acc[3] : 0.f);
                *(LAS u32x2*)(lds + AM + t * TS + s0 * 2) = w; } }
            const int tt = wid & 3, eh = wid >> 2;
            f32x4 oacc[4];
#pragma unroll
            for (int i = 0; i < 4; ++i) { oacc[i] = (f32x4){0.f, 0.f, 0.f, 0.f};
#pragma unroll
                for (int ks = 0; ks < 4; ++ks) { const bf16x8 af = *(const LAS bf16x8*)(lds + ST + ((eh * 4 + i) * 16 + fr) * RS + (ks * 32 + fq * 8) * 2), bq = *(const LAS bf16x8*)(lds + QH + (tt * 16 + fr) * RS + (ks * 32 + fq * 8) * 2); oacc[i] = MFMA16(af, bq, oacc[i]); } }
            __syncthreads();
#pragma unroll
            for (int i = 0; i < 4; ++i)
#pragma unroll
                for (int ks = 0; ks < 2; ++ks) { const bf16x8 af = *(const LAS bf16x8*)(lds + VT + ((eh * 4 + i) * 16 + fr) * TS + (ks * 32 + fq * 8) * 2), bq = *(const LAS bf16x8*)(lds + AM + (tt * 16 + fr) * TS + (ks * 32 + fq * 8) * 2); oacc[i] = MFMA16(af, bq, oacc[i]); }
            { const f32x4 dec = *(const LAS f32x4*)(lds + BLAST + (wid * 16 + fq * 4) * 4);
#pragma unroll
              for (int e = 0; e < 8; ++e) { sacc[e] = sacc[e] * dec;
#pragma unroll
                for (int ks = 0; ks < 2; ++ks) { const bf16x8 af = *(const LAS bf16x8*)(lds + KHT + (wid * 16 + fr) * TS + (ks * 32 + fq * 8) * 2), bq = *(const LAS bf16x8*)(lds + VT + (e * 16 + fr) * TS + (ks * 32 + fq * 8) * 2); sacc[e] = MFMA16(af, bq, sacc[e]); }
                u32x2 w; w.x = pk2(sacc[e][0], sacc[e][1]); w.y = pk2(sacc[e][2], sacc[e][3]);
                *(LAS u32x2*)(lds + ST + (e * 16 + fr) * RS + (wid * 16 + fq * 4) * 2) = w; } }
            { float s = 0.f;
#pragma unroll
              for (int i = 0; i < 4; ++i) s += (oacc[i][0] * oacc[i][0] + oacc[i][1] * oacc[i][1]) + (oacc[i][2] * oacc[i][2] + oacc[i][3] * oacc[i][3]);
              s += __shfl_xor(s, 16); s += __shfl_xor(s, 32);
              if (fq == 0) ((LAS float*)(lds + SSQX))[eh * 64 + tt * 16 + fr] = s; }
            __syncthreads();
            { const int t = tt * 16 + fr; const float tot = ((LAS float*)(lds + SSQX))[t] + ((LAS float*)(lds + SSQX))[64 + t];
              const float rstd = __builtin_amdgcn_rsqf(tot * (1.f / 128.f) + EPS);
              const size_t row = (size_t)b * SEQ + c * 64 + t;
#pragma unroll
              for (int i = 0; i < 4; ++i) { const int e0 = (eh * 4 + i) * 16 + fq * 4;
                const u32x2 g = *(const u32x2*)(P + row * 4096 + 3072 + h * 128 + e0); const f32x4 hv = *(const f32x4*)(hn + e0);
                u32x2 w; w.x = pk2(oacc[i][0] * rstd * hv[0] * bf2f(g.x), oacc[i][1] * rstd * hv[1] * bf2f(g.x >> 16)); w.y = pk2(oacc[i][2] * rstd * hv[2] * bf2f(g.y), oacc[i][3] * rstd * hv[3] * bf2f(g.y >> 16));
                *(u32x2*)(O + row * 1024 + h * 128 + e0) = w; } }
        }
    }
}

__device__ __forceinline__ void pool_phase(const float* x, const float* ssq, const float* gain, bf16_t* Ag, int G, int wg) {
    const int tid = opaque_tid(); const int c = 2 * tid, g = c >> 8, w = 2 << g;
    const f32x2 gn = *(const f32x2*)(gain + c);
    for (int u = wg; u < NB * 32; u += G) {
        const int b = u >> 5, t0 = (u & 31) * 64; const size_t rb = (size_t)b * SEQ;
        f32x2 win = (f32x2){0.f, 0.f};
        for (int i = w - 1; i >= 1; --i) { const int t = t0 - i; if (t >= 0) { const float rs = __builtin_amdgcn_rsqf(pg8::ssq_row(ssq, (int)(rb + t)) * (1.f / 1024.f) + EPS); const f32x2 xv = *(const f32x2*)(x + (rb + t) * 1024 + c); win += xv * rs * gn; } }
        for (int t = t0; t < t0 + 64; ++t) {
            const float rs = __builtin_amdgcn_rsqf(pg8::ssq_row(ssq, (int)(rb + t)) * (1.f / 1024.f) + EPS); const f32x2 hv = *(const f32x2*)(x + (rb + t) * 1024 + c) * rs * gn;
            win += hv; const float inv = 1.f / (float)((t + 1) < w ? (t + 1) : w);
            const f32x2 a = win * inv - hv;
            *(unsigned*)(Ag + ((size_t)g * MT + rb + t) * 256 + (c & 255)) = pk2(a.x, a.y);
            const int tt = t - w + 1;
            if (tt >= 0) { const float rs2 = __builtin_amdgcn_rsqf(pg8::ssq_row(ssq, (int)(rb + tt)) * (1.f / 1024.f) + EPS); const f32x2 xv = *(const f32x2*)(x + (rb + tt) * 1024 + c); win -= xv * rs2 * gn; }
        }
    }
}

__device__ __forceinline__ void final_phase(float* x, const float* ssq, const float* gain, int G, int wg) {
    const int tid = opaque_tid(), lane = tid & 63, wave = tid >> 6; const int gw = wg * 8 + wave, NGW = G * 8;
    f32x4 gv[4];
#pragma unroll
    for (int j = 0; j < 4; ++j) gv[j] = ((const f32x4*)gain)[lane + 64 * j];
    for (int m = gw; m < MT; m += NGW) {
        const float rs = __builtin_amdgcn_rsqf(pg8::ssq_row(ssq, m) * (1.f / 1024.f) + EPS);
        f32x4* xr = (f32x4*)(x + (size_t)m * DM) + lane;
#pragma unroll
        for (int j = 0; j < 4; ++j) xr[64 * j] = xr[64 * j] * rs * gv[j];
    }
}

constexpr int NPHASES = 22;
__global__ void __launch_bounds__(NTHREADS, 2) fwd_kernel(Args a) {
    extern __shared__ __attribute__((aligned(16))) unsigned char lds_raw[];
    LAS unsigned char* lds = (LAS unsigned char*)lds_raw;
    cg::grid_group grid = cg::this_grid();
    const int G = gridDim.x, wg = blockIdx.x;
    unsigned char* ws = a.ws;
    float* ssqA = (float*)(ws + WS_SSQ); float* ssqB = (float*)(ws + WS_SSQ1);
    bf16_t* XB = (bf16_t*)(ws + WS_XB); bf16_t* O2 = (bf16_t*)(ws + WS_O2); bf16_t* BIG = (bf16_t*)(ws + WS_BIG);
    const int lo = a.ph_lo, hi = a.ph_hi;
    int pid = 0;
#define PH_BEGIN if (pid >= lo && pid < hi) {
#define PH_END   if (pid + 1 < hi) grid.sync(); } ++pid;

    PH_BEGIN
#ifndef DIS_P0
 p0_phase(a, lds, G, wg);
#endif
 PH_END

    for (int i = 0; i < DEPTH; ++i) {
        const int mixer = i % 3, j = i / 3;
        const float* xold_mix = (i == 0) ? a.in[0] : a.out;
        if (mixer != 2) {
            PH_BEGIN
            pg8::Gemm g; pg8::EpiAct E;
            if (mixer == 0) { g = pg8::Gemm{XB, (const bf16_t*)(ws + WS_AWIN) + (size_t)j * 4096 * DM, MT, 4096, DM, 0}; E = pg8::EpiAct{BIG, 4096, ssqA, 0, (const float*)(ws + WS_LB) + j * 1024, 1.f}; }
            else { g = pg8::Gemm{XB, (const bf16_t*)(ws + WS_BQKV), MT, 3072, DM, 0}; E = pg8::EpiAct{BIG, 3072, ssqA, 1, nullptr, 0.08838834764831845f * 1.4426950408889634f}; }
            pg8::StaticOrder S; S.init(g.M, g.N, G, wg);

#ifndef DIS_GACT
 pg8::gemm_phase<pg8::EpiAct, pg8::StaticOrder, true, true>(lds, g, S, E);
#endif

            PH_END
        } else {
            PH_BEGIN pool_phase(a.out, ssqA, a.in[1] + i * DM, O2, G, wg); PH_END
        }
        if (mixer == 0) {
            PH_BEGIN
#ifndef DIS_GLA
 gla_phase(lds, BIG, a.in[6] + j * 128, O2, G, wg);
#endif
 PH_END
        } else if (mixer == 1) {
            PH_BEGIN kmean_phase(BIG, (float*)(ws + WS_KMEAN), G, wg); PH_END
            PH_BEGIN
#ifndef DIS_ATTN
 attn_phase(lds, BIG, (const float*)(ws + WS_KMEAN), (const float*)(ws + WS_BIAST), O2, G, wg);
#endif
 PH_END
        }
        {
            PH_BEGIN
            pg8::Gemm g;
            if (mixer == 0) g = pg8::Gemm{O2, (const bf16_t*)(ws + WS_AWOUT) + (size_t)j * DM * DM, MT, DM, DM, 0};
            else if (mixer == 1) g = pg8::Gemm{O2, (const bf16_t*)(ws + WS_BOUT), MT, DM, DM, 0};
            else g = pg8::Gemm{O2, (const bf16_t*)(ws + WS_CW), MT, DM, 256, (size_t)MT * 256 * 2};
            pg8::EpiRes E{xold_mix, a.out, XB, ssqB, mixer == 2 ? a.in[12] + j * DM : nullptr};
            pg8::StaticOrder S; S.init(g.M, g.N, G, wg);

#ifndef DIS_GRES
 pg8::gemm_phase<pg8::EpiRes, pg8::StaticOrder, true, true>(lds, g, S, E);
#endif

            PH_END
        }
        {
            PH_BEGIN
            pg8::Gemm g{XB, (const bf16_t*)(ws + WS_W1) + (size_t)i * FF * DM, MT, FF, DM, 0};
            pg8::EpiAct E{BIG, FF, ssqB, 2, nullptr, 1.f};
            pg8::StaticOrder S; S.init(g.M, g.N, G, wg);

#ifndef DIS_GACT
 pg8::gemm_phase<pg8::EpiAct, pg8::StaticOrder, true, true>(lds, g, S, E);
#endif

            PH_END
        }
        {
            PH_BEGIN
            pg8::Gemm g{BIG, (const bf16_t*)(ws + WS_W2) + (size_t)i * DM * FF, MT, DM, FF, 0};
            pg8::EpiRes E{a.out, a.out, XB, ssqA, nullptr};
            pg8::StaticOrder S; S.init(g.M, g.N, G, wg);

#ifndef DIS_GRES
 pg8::gemm_phase<pg8::EpiRes, pg8::StaticOrder, true, true>(lds, g, S, E);
#endif

            PH_END
        }
    }
    PH_BEGIN final_phase(a.out, ssqA, a.in[3], G, wg); PH_END
#undef PH_BEGIN
#undef PH_END
}

extern "C" void kernel_launch(void* const* d_in, const int* in_sizes, int n_in, void* d_out, int out_size, void* d_ws, size_t ws_size, hipStream_t stream) {
    static int grid = 0;
    if (grid == 0) {
        if (n_in != 15 || in_sizes[0] != MT * DM || out_size != MT * DM || ws_size < WS_END) { fprintf(stderr, "kernel_launch: unexpected shapes (n_in %d, in0 %d, out %d, ws %zu need %zu)\n", n_in, n_in > 0 ? in_sizes[0] : -1, out_size, ws_size, (size_t)WS_END); grid = -1; return; }
        int dev = 0, cus = 0, per_cu = 0;
        hipGetDevice(&dev); hipDeviceGetAttribute(&cus, hipDeviceAttributeMultiprocessorCount, dev);
        hipFuncSetAttribute((const void*)fwd_kernel, hipFuncAttributeMaxDynamicSharedMemorySize, LDS_BYTES);
        hipOccupancyMaxActiveBlocksPerMultiprocessor(&per_cu, (const void*)fwd_kernel, NTHREADS, LDS_BYTES);
        (void)hipGetLastError();
        if (per_cu < 1) per_cu = 1;
        grid = cus * per_cu;
        fprintf(stderr, "kernel_launch: grid %d (cus %d x %d)\n", grid, cus, per_cu);
    }
    if (grid < 0) return;
    Args a{};
    for (int i = 0; i < 15; ++i) a.in[i] = (const float*)d_in[i];
    a.out = (float*)d_out; a.ws = (unsigned char*)d_ws;
#if ONE_LAUNCH
    a.ph_lo = 0; a.ph_hi = NPHASES;
    void* args[] = {&a};
    hipError_t e = hipLaunchCooperativeKernel((const void*)fwd_kernel, dim3(grid), dim3(NTHREADS), args, LDS_BYTES, stream);
    if (e != hipSuccess) fprintf(stderr, "cooperative launch failed: %s (grid %d)\n", hipGetErrorString(e), grid);
#else
    for (int p = 0; p < NPHASES; ++p) {
        a.ph_lo = p; a.ph_hi = p + 1;
        hipLaunchKernelGGL(fwd_kernel, dim3(grid), dim3(NTHREADS), LDS_BYTES, stream, a);
    }
#endif
}
```

```cpp
#include <hip/hip_runtime.h>
#include <hip/hip_cooperative_groups.h>
#include <cstdio>
#include <cstdint>
namespace cg = cooperative_groups;

#ifndef ONE_LAUNCH
#define ONE_LAUNCH 1
#endif

__device__ __forceinline__ int opaque_tid() { int t = threadIdx.x; asm volatile("" : "+v"(t)); return t; }
namespace pg8 {
#define PG8_LAS __attribute__((address_space(3)))
typedef unsigned short bf16_t;
typedef short bf16x8 __attribute__((ext_vector_type(8)));
typedef float f32x4 __attribute__((ext_vector_type(4)));
typedef unsigned u32x4 __attribute__((ext_vector_type(4)));
typedef unsigned u32x2 __attribute__((ext_vector_type(2)));
constexpr int BM = 256, BK = 64, HALF = 128, HTB = HALF * BK * 2  , STAGE_BYTES = 8 * HTB, NXCD = 8, WGM = 8;

__host__ __device__ __forceinline__ int lds_byte(int r, int c) { const int st = (r >> 4) * 2 + (c >> 5), rr = r & 15, cc = c & 31, ob = rr * 64 + cc * 2; return st * 1024 + (ob ^ (((ob >> 9) & 1) << 5)); }
__host__ __device__ __forceinline__ void stage_rc(int b, int& R, int& C) { const int st = b / 1024, sb = b % 1024, swz = sb ^ (((sb >> 9) & 1) << 5); R = (st >> 1) * 16 + swz / 64; C = (st & 1) * 32 + (swz % 64) / 2; }
__host__ __device__ __forceinline__ int perm32(int rho) { const int n = rho >> 4, i = rho & 15; return 8 * (i >> 2) + 4 * n + (i & 3); }

struct Unit { int pm, pn; };
struct Gemm { const bf16_t* A; const bf16_t* Bt; int M, N, K; size_t a_gs; };

struct StaticOrder {
    int nM, nN, nwg, G, c;
    __host__ __device__ void init(int M, int N, int G_, int c_) { nM = M / BM; nN = N / BM; nwg = nM * nN; G = G_; c = c_; }
    __host__ __device__ bool next(int i, Unit& u) const {
        const long L = (long)i * G + c; if (L >= nwg) return false;
        int wgid = (int)L; { const int q = nwg / NXCD, r = nwg % NXCD, xcd = wgid % NXCD, off = wgid / NXCD; wgid = (xcd < r ? xcd * (q + 1) : r * (q + 1) + (xcd - r) * q) + off; }
        const int nig = WGM * nN, gid = wgid / nig, fm = gid * WGM, gsz = (nM - fm) < WGM ? (nM - fm) : WGM;
        u.pm = fm + ((wgid % nig) % gsz); u.pn = (wgid % nig) / gsz; return true;
    }
    __device__ __forceinline__ void a_ready(const Unit&) const {}
    __device__ __forceinline__ void done(const Unit&) const {}
};

__device__ __forceinline__ unsigned cvt_pk_bf16(float lo, float hi) { unsigned r; asm volatile("v_cvt_pk_bf16_f32 %0, %1, %2" : "=v"(r) : "v"(lo), "v"(hi)); return r; }

constexpr float RMS_EPS = 1e-6f;
constexpr int RSTD_TAB = STAGE_BYTES;
__device__ __forceinline__ float ssq_row(const float* part, int row) {
    const f32x4* p = (const f32x4*)(part + (size_t)row * 16);
    const f32x4 a = p[0], b = p[1], c = p[2], d = p[3];
    return (((a[0] + a[1]) + (a[2] + a[3])) + ((b[0] + b[1]) + (b[2] + b[3]))) + (((c[0] + c[1]) + (c[2] + c[3])) + ((d[0] + d[1]) + (d[2] + d[3])));
}
__device__ __forceinline__ float silu_f(float v) { return v * __builtin_amdgcn_rcpf(1.f + __expf(-v)); }

struct EpiAct {
    static constexpr bool PERM = true, AFTER_DRAIN = false;
    bf16_t* O; int ldc; const float* ssq; int mode; const float* lb; float qscale; float* kmean; int use_tab;
    __device__ __forceinline__ void operator()(const f32x4 (&acc)[2][2][4][2], const Unit& u, int wr, int wc, int fr, int fq, int ui, PG8_LAS unsigned char* lds) const {
        const int row0 = u.pm * BM + wr * 64 + fr, col0 = u.pn * BM + wc * 32 + 8 * fq;
        const PG8_LAS float* tab = (const PG8_LAS float*)(lds + RSTD_TAB) + ui * 256 + wr * 64 + fr;
        const int sec = (u.pn * BM) >> 10;
        int act = 0; float sc = 1.f;
        if (mode == 0) act = (sec == 0 || sec == 3) ? 1 : (sec == 1 ? 2 : 0);
        else if (mode == 1) sc = (sec == 0) ? qscale : 1.f;
        else act = 3;
        const bool ksum = (mode == 1) && (sec == 1);
        f32x4 csum[2][2] = {{(f32x4){0.f, 0.f, 0.f, 0.f}, (f32x4){0.f, 0.f, 0.f, 0.f}}, {(f32x4){0.f, 0.f, 0.f, 0.f}, (f32x4){0.f, 0.f, 0.f, 0.f}}};
#pragma unroll
        for (int ai = 0; ai < 2; ++ai) {
            float rs4[4];
#pragma unroll
            for (int m = 0; m < 4; ++m) {
                if ((m & 1) == 0) {
                    if (use_tab) { rs4[m] = tab[ai * HALF + m * 16] * sc; rs4[m + 1] = tab[ai * HALF + (m + 1) * 16] * sc; }
                    else {
                        asm volatile("" ::: "memory");
                        rs4[m] = __builtin_amdgcn_rsqf(ssq_row(ssq, row0 + ai * HALF + m * 16) * (1.0f / 1024.0f) + RMS_EPS) * sc;
                        rs4[m + 1] = __builtin_amdgcn_rsqf(ssq_row(ssq, row0 + ai * HALF + (m + 1) * 16) * (1.0f / 1024.0f) + RMS_EPS) * sc;
                    }
                }
                const int row = row0 + ai * HALF + m * 16;
                const float rs = rs4[m];
                bf16_t* rowp = O + (size_t)row * ldc + col0;
#pragma unroll
                for (int bj = 0; bj < 2; ++bj) {
                    f32x4 v[2] = {acc[ai][bj][m][0] * rs, acc[ai][bj][m][1] * rs};
                    if (ksum) { csum[bj][0] += v[0]; csum[bj][1] += v[1]; }
#pragma unroll
                    for (int n = 0; n < 2; ++n) {
                        f32x4 lbv = (f32x4){0.f, 0.f, 0.f, 0.f};
                        if (act == 2) lbv = *(const f32x4*)(lb + (col0 - 1024) + bj * HALF + 4 * n);
#pragma unroll
                        for (int e = 0; e < 4; ++e) {
                            float x = v[n][e];
                            if (act == 1) x = silu_f(x);
                            else if (act == 2) { const float l = lbv[e]; x = __logf(l + (1.f - l) * __builtin_amdgcn_rcpf(1.f + __expf(-x))); }
                            else if (act == 3) { x = fmaxf(x, 0.f); x = x * x; }
                            v[n][e] = x;
                        }
                    }
                    u32x4 w; w.x = cvt_pk_bf16(v[0][0], v[0][1]); w.y = cvt_pk_bf16(v[0][2], v[0][3]); w.z = cvt_pk_bf16(v[1][0], v[1][1]); w.w = cvt_pk_bf16(v[1][2], v[1][3]);
                    *(u32x4*)(rowp + bj * HALF) = w;
                }
            }
        }
        if (ksum) {
            const int b = u.pm >> 3, nblk = u.pm & 7;
#pragma unroll
            for (int bj = 0; bj < 2; ++bj)
#pragma unroll
                for (int n = 0; n < 2; ++n)
#pragma unroll
                    for (int e = 0; e < 4; ++e) {
                        float t = csum[bj][n][e];
                        t += __shfl_xor(t, 1); t += __shfl_xor(t, 2); t += __shfl_xor(t, 4); t += __shfl_xor(t, 8);
                        if (fr == 0) { const int kc = col0 + bj * HALF + 4 * n + e - 1024, h = kc >> 7, d = kc & 127;
                            atomicAdd(kmean + ((size_t)((b * 8 + h) * 8 + nblk)) * 128 + d, t * (1.0f / 256.0f)); }
                    }
        }
    }
};

struct EpiRes {
    static constexpr bool PERM = true, AFTER_DRAIN = false;
    bf16_t* xb; float* ssq_next; const float* cscale; int dry;
    __device__ __forceinline__ void operator()(const f32x4 (&acc)[2][2][4][2], const Unit& u, int wr, int wc, int fr, int fq, int, PG8_LAS unsigned char*) const {
        const int row0 = u.pm * BM + wr * 64 + fr, col0 = u.pn * BM + wc * 32 + 8 * fq;
        f32x4 csv[2][2];
#pragma unroll
        for (int bj = 0; bj < 2; ++bj)
#pragma unroll
            for (int n = 0; n < 2; ++n) { csv[bj][n] = (f32x4){1.f, 1.f, 1.f, 1.f}; if (cscale) csv[bj][n] = *(const f32x4*)(cscale + col0 + bj * HALF + 4 * n); }
#pragma unroll
        for (int ai = 0; ai < 2; ++ai) {
            u32x4 xw[4][2];
#pragma unroll
            for (int m = 0; m < 4; ++m)
#pragma unroll
                for (int bj = 0; bj < 2; ++bj) xw[m][bj] = *(const u32x4*)(xb + (size_t)(row0 + ai * HALF + m * 16) * 1024 + col0 + bj * HALF);
#pragma unroll
            for (int m = 0; m < 4; ++m) {
                const int row = row0 + ai * HALF + m * 16; const size_t off = (size_t)row * 1024 + col0;
                float s = 0.f;
#pragma unroll
                for (int bj = 0; bj < 2; ++bj) {
                    const u32x4 xv = xw[m][bj];
                    const f32x4 xo0 = {__builtin_bit_cast(float, xv.x << 16), __builtin_bit_cast(float, xv.x & 0xffff0000u), __builtin_bit_cast(float, xv.y << 16), __builtin_bit_cast(float, xv.y & 0xffff0000u)};
                    const f32x4 xo1 = {__builtin_bit_cast(float, xv.z << 16), __builtin_bit_cast(float, xv.z & 0xffff0000u), __builtin_bit_cast(float, xv.w << 16), __builtin_bit_cast(float, xv.w & 0xffff0000u)};
                    const f32x4 o0 = xo0 + acc[ai][bj][m][0] * csv[bj][0], o1 = xo1 + acc[ai][bj][m][1] * csv[bj][1];
                    u32x4 w; w.x = cvt_pk_bf16(o0[0], o0[1]); w.y = cvt_pk_bf16(o0[2], o0[3]); w.z = cvt_pk_bf16(o1[0], o1[1]); w.w = cvt_pk_bf16(o1[2], o1[3]);
                    if (!dry) *(u32x4*)(xb + off + bj * HALF) = w;
#pragma unroll
                    for (int q = 0; q < 4; ++q) { const unsigned ww = w[q]; const float ra = __builtin_bit_cast(float, ww << 16), rb = __builtin_bit_cast(float, ww & 0xffff0000u); s += ra * ra + rb * rb; }
                }
                s += __shfl_xor(s, 16); s += __shfl_xor(s, 32);
                if (fq == 0 && !dry) ssq_next[(size_t)row * 16 + u.pn * 4 + wc] = s;
            }
            asm volatile("" ::: "memory");
        }
    }
};

template <class Epi, class Sched, bool ALIGN_EPI = false, bool SP2 = false>
__device__ __forceinline__ void gemm_phase(PG8_LAS unsigned char* lds, const Gemm g, const Sched& S, const Epi& E) {
    const int tid = opaque_tid(), wid = __builtin_amdgcn_readfirstlane(tid >> 6), lane = tid & 63, wr = wid >> 2, wc = wid & 3, fr = lane & 15, fq = lane >> 4;
    const int K = g.K, nt = K / BK;
    unsigned voffA[2], voffB[2];
#pragma unroll
    for (int i = 0; i < 2; ++i) { int R, C; stage_rc(tid * 16 + i * 8192, R, C); const int Rb = Epi::PERM ? ((R & ~31) + perm32(R & 31)) : R;
        voffA[i] = (unsigned)(R * K + C) * 2u; voffB[i] = (unsigned)(Rb * K + C) * 2u; }
    const size_t kstep = (size_t)(BK * 2);
    const size_t hstep = (size_t)HALF * K * 2;
    const size_t tstep = 2 * hstep;
    const unsigned ldsw = (unsigned)wid * 1024u;
    const int aoff = lds_byte(wr * 64 + fr, fq * 8), boff = lds_byte(wc * 32 + fr, fq * 8);
#define PG8_SA(b, h) (((b) * 2 + (h)) * HTB)
#define PG8_SB(b, h) ((4 + (b) * 2 + (h)) * HTB)
#define PG8_STAGE(bufoff, gbase, voff) do { _Pragma("unroll") for (int _i = 0; _i < 2; ++_i) \
        __builtin_amdgcn_global_load_lds((const unsigned*)((const char*)(gbase) + (voff)[_i]), (PG8_LAS unsigned*)(lds + (bufoff) + ldsw + _i * 8192), 16, 0, 0); } while (0)
#define PG8_LDA(dst, b, h) do { _Pragma("unroll") for (int m = 0; m < 4; ++m) _Pragma("unroll") for (int k = 0; k < 2; ++k) dst[m][k] = *(const PG8_LAS bf16x8*)(lds + PG8_SA(b, h) + aoff + m * 2048 + k * 1024); } while (0)
#define PG8_LDB(dst, b, h) do { _Pragma("unroll") for (int n = 0; n < 2; ++n) _Pragma("unroll") for (int k = 0; k < 2; ++k) dst[n][k] = *(const PG8_LAS bf16x8*)(lds + PG8_SB(b, h) + boff + n * 2048 + k * 1024); } while (0)
#define PG8_MMA(ai, bj, At, Bt) do { __builtin_amdgcn_s_setprio(1); _Pragma("unroll") for (int m = 0; m < 4; ++m) _Pragma("unroll") for (int n = 0; n < 2; ++n) _Pragma("unroll") for (int k = 0; k < 2; ++k) \
        acc[ai][bj][m][n] = __builtin_amdgcn_mfma_f32_16x16x32_bf16(Bt[n][k], At[m][k], acc[ai][bj][m][n], 0, 0, 0); __builtin_amdgcn_s_setprio(0); } while (0)
#define PG8_WAIT_V(n) asm volatile("s_waitcnt vmcnt(" #n ")" ::: "memory")
#define PG8_WAIT_L(n) asm volatile("s_waitcnt lgkmcnt(" #n ")" ::: "memory")
#define PG8_BAR __builtin_amdgcn_s_barrier()
#define PG8_SCHED __builtin_amdgcn_sched_barrier(0)
    Unit cur, nxt; int ui = 0;
    if (!S.next(0, cur)) return;
    f32x4 acc[2][2][4][2];
#pragma unroll
    for (int a = 0; a < 2; ++a)
#pragma unroll
        for (int b = 0; b < 2; ++b)
#pragma unroll
            for (int m = 0; m < 4; ++m)
#pragma unroll
                for (int n = 0; n < 2; ++n) acc[a][b][m][n] = (f32x4){0.f, 0.f, 0.f, 0.f};
    bf16x8 At[4][2], B0[2][2], B1[2][2];
    const char* cA = (const char*)g.A + (size_t)cur.pm * tstep + (size_t)cur.pn * g.a_gs; const char* cB = (const char*)g.Bt + (size_t)cur.pn * tstep;
    S.a_ready(cur);
    if constexpr (SP2) {
        PG8_STAGE(PG8_SB(0, 0), cB, voffB); PG8_STAGE(PG8_SB(0, 1), cB + hstep, voffB); PG8_STAGE(PG8_SA(0, 0), cA, voffA); PG8_STAGE(PG8_SA(0, 1), cA + hstep, voffA);
        if (wr == 1) PG8_BAR;
        PG8_WAIT_V(2); PG8_BAR;
        PG8_STAGE(PG8_SB(1, 0), cB + kstep, voffB); PG8_STAGE(PG8_SA(1, 0), cA + kstep, voffA); PG8_STAGE(PG8_SB(1, 1), cB + hstep + kstep, voffB);
        PG8_WAIT_V(6); PG8_BAR;
    } else {
        PG8_STAGE(PG8_SB(0, 0), cB, voffB); PG8_STAGE(PG8_SA(0, 0), cA, voffA); PG8_STAGE(PG8_SB(0, 1), cB + hstep, voffB); PG8_STAGE(PG8_SA(0, 1), cA + hstep, voffA);
        if (wr == 1) PG8_BAR;
        PG8_WAIT_V(4); PG8_BAR;
        PG8_STAGE(PG8_SB(1, 0), cB + kstep, voffB); PG8_STAGE(PG8_SA(1, 0), cA + kstep, voffA); PG8_STAGE(PG8_SB(1, 1), cB + hstep + kstep, voffB);
        PG8_WAIT_V(6); PG8_BAR;
    }
    for (;;) {
        const bool has_next = S.next(ui + 1, nxt);
        const char* nA = has_next ? (const char*)g.A + (size_t)nxt.pm * tstep + (size_t)nxt.pn * g.a_gs : cA; const char* nB = has_next ? (const char*)g.Bt + (size_t)nxt.pn * tstep : cB;
        for (int t = 0; t < nt; t += 2) {
            const bool last = (t == nt - 2);
            const char* a1 = cA + (size_t)(t + 1) * kstep;
            const char* a2 = last ? nA : cA + (size_t)(t + 2) * kstep; const char* b2 = last ? nB : cB + (size_t)(t + 2) * kstep;
            const char* a3 = a2 + kstep; const char* b3 = b2 + kstep;
            if (last && has_next) S.a_ready(nxt);
            if constexpr (SP2) {
            PG8_LDB(B0, 0, 0); PG8_LDB(B1, 0, 1); PG8_SCHED; PG8_LDA(At, 0, 0); PG8_STAGE(PG8_SA(1, 1), a1 + hstep, voffA);
            PG8_WAIT_V(8); PG8_WAIT_L(0); PG8_BAR; PG8_MMA(0, 0, At, B0); PG8_MMA(0, 1, At, B1); PG8_BAR; PG8_SCHED;
            PG8_LDA(At, 0, 1); PG8_STAGE(PG8_SB(0, 0), b2, voffB); PG8_STAGE(PG8_SB(0, 1), b2 + hstep, voffB); PG8_STAGE(PG8_SA(0, 0), a2, voffA);
            PG8_WAIT_V(8); PG8_WAIT_L(0); PG8_BAR; PG8_MMA(1, 0, At, B0); PG8_MMA(1, 1, At, B1); PG8_BAR; PG8_SCHED;
            PG8_LDB(B0, 1, 0); PG8_LDB(B1, 1, 1); PG8_SCHED; PG8_LDA(At, 1, 0); PG8_STAGE(PG8_SA(0, 1), a2 + hstep, voffA);
            PG8_WAIT_V(8); PG8_WAIT_L(0); PG8_BAR; PG8_MMA(0, 0, At, B0); PG8_MMA(0, 1, At, B1); PG8_BAR; PG8_SCHED;
            PG8_LDA(At, 1, 1); PG8_STAGE(PG8_SB(1, 0), b3, voffB); PG8_STAGE(PG8_SB(1, 1), b3 + hstep, voffB); PG8_STAGE(PG8_SA(1, 0), a3, voffA);
            PG8_WAIT_V(8); PG8_WAIT_L(0); PG8_BAR; PG8_MMA(1, 0, At, B0); PG8_MMA(1, 1, At, B1); PG8_BAR; PG8_SCHED;
            } else {
            PG8_LDB(B0, 0, 0); PG8_SCHED; PG8_LDA(At, 0, 0); PG8_STAGE(PG8_SA(1, 1), a1 + hstep, voffA);
            PG8_WAIT_L(8); PG8_BAR; PG8_WAIT_L(0); PG8_MMA(0, 0, At, B0); PG8_BAR; PG8_SCHED;
            PG8_LDB(B1, 0, 1); PG8_STAGE(PG8_SB(0, 0), b2, voffB);
            PG8_BAR; PG8_WAIT_L(0); PG8_MMA(0, 1, At, B1); PG8_BAR;
            PG8_LDA(At, 0, 1); PG8_STAGE(PG8_SA(0, 0), a2, voffA);
            PG8_BAR; PG8_WAIT_L(0); PG8_MMA(1, 0, At, B0); PG8_BAR; PG8_SCHED;
            PG8_STAGE(PG8_SB(0, 1), b2 + hstep, voffB);
            PG8_WAIT_V(6); PG8_BAR; PG8_MMA(1, 1, At, B1); PG8_BAR;
            PG8_LDB(B0, 1, 0); PG8_SCHED; PG8_LDA(At, 1, 0); PG8_STAGE(PG8_SA(0, 1), a2 + hstep, voffA);
            PG8_WAIT_L(8); PG8_BAR; PG8_WAIT_L(0); PG8_MMA(0, 0, At, B0); PG8_BAR; PG8_SCHED;
            PG8_LDB(B1, 1, 1); PG8_STAGE(PG8_SB(1, 0), b3, voffB);
            PG8_BAR; PG8_WAIT_L(0); PG8_MMA(0, 1, At, B1); PG8_BAR;
            PG8_LDA(At, 1, 1); PG8_STAGE(PG8_SA(1, 0), a3, voffA);
            PG8_BAR; PG8_WAIT_L(0); PG8_MMA(1, 0, At, B0); PG8_BAR; PG8_SCHED;
            PG8_STAGE(PG8_SB(1, 1), b3 + hstep, voffB);
            PG8_WAIT_V(6); PG8_BAR; PG8_MMA(1, 1, At, B1); PG8_BAR;
            }
        }
        if constexpr (ALIGN_EPI) { if (wr == 0) PG8_BAR; }
        if constexpr (!Epi::AFTER_DRAIN) { E(acc, cur, wr, wc, fr, fq, ui, lds); S.done(cur); }
        if (!has_next) break;
#pragma unroll
        for (int a = 0; a < 2; ++a)
#pragma unroll
            for (int b = 0; b < 2; ++b)
#pragma unroll
                for (int m = 0; m < 4; ++m)
#pragma unroll
                    for (int n = 0; n < 2; ++n) acc[a][b][m][n] = (f32x4){0.f, 0.f, 0.f, 0.f};
        cur = nxt; cA = nA; cB = nB; ++ui;
        if constexpr (ALIGN_EPI) { if (wr == 1) PG8_BAR; }
    }
    PG8_WAIT_V(0);
    if constexpr (!ALIGN_EPI) { if (wr == 0) PG8_BAR; }
    PG8_BAR;
    if constexpr (Epi::AFTER_DRAIN) { E.fused(acc, cur, wr, wc, fr, fq, lds, wid, lane); S.done(cur); }
#undef PG8_SA
#undef PG8_SB
#undef PG8_STAGE
#undef PG8_LDA
#undef PG8_LDB
#undef PG8_MMA
#undef PG8_WAIT_V
#undef PG8_WAIT_L
#undef PG8_BAR
#undef PG8_SCHED
}
}

#define LAS __attribute__((address_space(3)))
typedef unsigned short bf16_t;
typedef short bf16x8 __attribute__((ext_vector_type(8)));
typedef short s16x4 __attribute__((ext_vector_type(4)));
typedef float f32x4 __attribute__((ext_vector_type(4)));
typedef float f32x2 __attribute__((ext_vector_type(2)));
typedef unsigned u32x4 __attribute__((ext_vector_type(4)));
typedef unsigned u32x2 __attribute__((ext_vector_type(2)));

constexpr int NB = 16, SEQ = 2048, DM = 1024, MT = NB * SEQ, FF = 4096, NH = 8, HD = 128, DEPTH = 4;
constexpr float EPS = 1e-6f;
constexpr size_t MiB = 1u << 20;
constexpr int NB_C = 16;
constexpr int LDS_BYTES_C = 147456;
constexpr size_t WS_SSQ = 0;
constexpr size_t WS_KMEAN = 484 * MiB;
constexpr size_t KM_Q = (size_t)NB_C * 8 * 8 * 128;
constexpr size_t WS_BIAST = 2 * MiB + 768 * 1024;
constexpr size_t WS_LB = 3 * MiB;
constexpr size_t WS_BAR = 3 * MiB + 64 * 1024;
constexpr int LDS_BARST = LDS_BYTES_C - 64;
constexpr size_t WS_AWIN = 4 * MiB, WS_AWOUT = 20 * MiB, WS_BQKV = 24 * MiB, WS_BOUT = 30 * MiB, WS_CW = 32 * MiB, WS_W1 = 33 * MiB, WS_W2 = 65 * MiB;
constexpr size_t WS_XB = 98 * MiB, WS_O2 = 162 * MiB, WS_BIG = 226 * MiB, WS_SSQ1 = 482 * MiB, WS_END = 486 * MiB;
constexpr int LDS_BYTES = 147456;
constexpr int NTHREADS = 512;

__device__ __forceinline__ unsigned f2bf(float f) { unsigned u = __builtin_bit_cast(unsigned, f); return (u + 0x7fffu + ((u >> 16) & 1u)) >> 16; }
typedef __bf16 bf16x2_t __attribute__((ext_vector_type(2)));
__device__ __forceinline__ unsigned pk2(float lo, float hi) { f32x2 v = {lo, hi}; bf16x2_t b = __builtin_convertvector(v, bf16x2_t); return __builtin_bit_cast(unsigned, b); }
__device__ __forceinline__ float bf2f(unsigned h) { return __builtin_bit_cast(float, (h & 0xffffu) << 16); }
__device__ __forceinline__ float wave_sum(float v) {
#pragma unroll
    for (int o = 1; o < 64; o <<= 1) v += __shfl_xor(v, o);
    return v;
}
__device__ __forceinline__ u32x4 pair_tiles(u32x2 wa, u32x2 wb, int fq) {
    const bool odd = fq & 1;
    const unsigned sx = odd ? wa.x : wb.x, sy = odd ? wa.y : wb.y;
    const unsigned rx = (unsigned)__shfl_xor((int)sx, 16), ry = (unsigned)__shfl_xor((int)sy, 16);
    return odd ? (u32x4){rx, ry, wb.x, wb.y} : (u32x4){wa.x, wa.y, rx, ry};
}
#define MFMA16(a, b, c) __builtin_amdgcn_mfma_f32_16x16x32_bf16((a), (b), (c), 0, 0, 0)
#define LDS_WAIT() asm volatile("s_waitcnt lgkmcnt(0)" ::: "memory")
#define LDS_BARRIER() asm volatile("s_waitcnt lgkmcnt(0)\n\ts_barrier" ::: "memory")

__device__ __forceinline__ void p0_cvt_item(const float* W, int K, int N, bf16_t* WT, int row_off, const float* gain, int item, int lane) {
    const int nblk = N / 256, kb = item / nblk, nb = item % nblk, k0 = 64 * kb, n0 = 256 * nb + 4 * lane;
#pragma unroll 2
    for (int kk = 0; kk < 64; kk += 8) {
        f32x4 v[8];
#pragma unroll
        for (int j = 0; j < 8; ++j) { const float gk = gain ? gain[k0 + kk + j] : 1.f; v[j] = *(const f32x4*)(W + (size_t)(k0 + kk + j) * N + n0) * gk; }
#pragma unroll
        for (int c = 0; c < 4; ++c) { u32x4 o; o.x = pk2(v[0][c], v[1][c]); o.y = pk2(v[2][c], v[3][c]); o.z = pk2(v[4][c], v[5][c]); o.w = pk2(v[6][c], v[7][c]);
            *(u32x4*)(WT + (size_t)(row_off + n0 + c) * K + k0 + kk) = o; }
    }
}

struct Args {
    const float* in[15]; float* out; unsigned char* ws; int ph_lo, ph_hi;
};

__device__ __forceinline__ int t5_bucket(int n) {
    if (n < 16) return n;
    const float v = (__log2f((float)n * (1.0f / 16.0f)) * 16.0f) / 6.0f;
    int l = 16 + (int)v; return l < 31 ? l : 31;
}

__device__ __forceinline__ void p0_phase(const Args& a, LAS unsigned char* lds, int G, int wg, int part, bool split) {
    const int tid = opaque_tid(), lane = tid & 63, wave = tid >> 6;
    unsigned char* ws = a.ws;
    const float* norm_mix = a.in[1]; const float* norm_mlp = a.in[2];
    const int gw = wg * 8 + wave, NGW = G * 8;
    constexpr int I_AIN = (DM / 64) * (4096 / 256), I_SQ = (DM / 64) * (DM / 256), I_QKV = (DM / 64) * (3072 / 256), I_CW = (256 / 64) * (256 / 256), I_W1 = (DM / 64) * (FF / 256), I_W2 = (FF / 64) * (DM / 256);
    constexpr int NITEMS = 2 * I_AIN + 2 * I_SQ + I_QKV + I_SQ + 4 * I_CW + 4 * I_W1 + 4 * I_W2;
    constexpr int LATE0 = 2 * I_AIN + I_SQ + I_QKV + I_SQ + 4 * I_CW + 3 * I_W1 + 3 * I_W2;
    const int it_lo = !split ? 0 : (part == 0 ? 0 : (part == 1 ? I_AIN : LATE0)), it_hi = !split ? NITEMS : (part == 0 ? I_AIN : (part == 1 ? LATE0 : NITEMS));
    for (int it = it_lo + gw; it < it_hi; it += NGW) {
        int r = it;
        if (r < 2 * I_AIN) { const int j = r / I_AIN; r -= j * I_AIN;
            p0_cvt_item(a.in[4] + (size_t)j * DM * 4096, DM, 4096, (bf16_t*)(ws + WS_AWIN) + (size_t)j * 4096 * DM, 0, norm_mix + (3 * j) * DM, r, lane); continue; } r -= 2 * I_AIN;
        if (r < I_SQ) { p0_cvt_item(a.in[7], DM, DM, (bf16_t*)(ws + WS_AWOUT), 0, nullptr, r, lane); continue; } r -= I_SQ;
        if (r < I_QKV) { p0_cvt_item(a.in[8], DM, 3072, (bf16_t*)(ws + WS_BQKV), 0, norm_mix + 1 * DM, r, lane); continue; } r -= I_QKV;
        if (r < I_SQ) { p0_cvt_item(a.in[9], DM, DM, (bf16_t*)(ws + WS_BOUT), 0, nullptr, r, lane); continue; } r -= I_SQ;
        if (r < 4 * I_CW) { const int g = r / I_CW; r -= g * I_CW;
            p0_cvt_item(a.in[11] + (size_t)g * 256 * 256, 256, 256, (bf16_t*)(ws + WS_CW), g * 256, nullptr, r, lane); continue; } r -= 4 * I_CW;
        if (r < 3 * I_W1) { const int j = r / I_W1; r -= j * I_W1;
            p0_cvt_item(a.in[13] + (size_t)j * DM * FF, DM, FF, (bf16_t*)(ws + WS_W1) + (size_t)j * FF * DM, 0, norm_mlp + j * DM, r, lane); continue; } r -= 3 * I_W1;
        if (r < 3 * I_W2) { const int j = r / I_W2; r -= j * I_W2;
            p0_cvt_item(a.in[14] + (size_t)j * FF * DM, FF, DM, (bf16_t*)(ws + WS_W2) + (size_t)j * DM * FF, 0, nullptr, r, lane); continue; } r -= 3 * I_W2;
        if (r < I_SQ) { p0_cvt_item(a.in[7] + (size_t)DM * DM, DM, DM, (bf16_t*)(ws + WS_AWOUT) + (size_t)DM * DM, 0, nullptr, r, lane); continue; } r -= I_SQ;
        if (r < I_W1) { p0_cvt_item(a.in[13] + (size_t)3 * DM * FF, DM, FF, (bf16_t*)(ws + WS_W1) + (size_t)3 * FF * DM, 0, norm_mlp + 3 * DM, r, lane); continue; } r -= I_W1;
        p0_cvt_item(a.in[14] + (size_t)3 * FF * DM, FF, DM, (bf16_t*)(ws + WS_W2) + (size_t)3 * DM * FF, 0, nullptr, r, lane);
    }
    if (part != 0) return;
    const float* x = a.in[0]; float* ssq = (float*)(ws + WS_SSQ); bf16_t* xb = (bf16_t*)(ws + WS_XB);
    for (int m0 = gw; m0 < MT; m0 += 4 * NGW) {
        f32x4 v[4][4];
#pragma unroll
        for (int q = 0; q < 4; ++q) { const int m = m0 + q * NGW; const f32x4* xr = (const f32x4*)(x + (size_t)(m < MT ? m : m0) * DM) + lane;
#pragma unroll
            for (int j = 0; j < 4; ++j) v[q][j] = xr[64 * j]; }
#pragma unroll
        for (int q = 0; q < 4; ++q) { const int m = m0 + q * NGW; if (m >= MT) break;
            unsigned long long* o8 = (unsigned long long*)(xb + (size_t)m * DM) + lane; float s = 0.f;
#pragma unroll
            for (int j = 0; j < 4; ++j) { const f32x4 t = v[q][j]; s += (t.x * t.x + t.y * t.y) + (t.z * t.z + t.w * t.w);
                o8[64 * j] = (unsigned long long)pk2(t.x, t.y) | ((unsigned long long)pk2(t.z, t.w) << 32); }
            s = wave_sum(s);
            if (lane < 16) ssq[(size_t)m * 16 + lane] = (lane == 0) ? s : 0.f; }
    }
    const int gt = wg * NTHREADS + tid, NGT = G * NTHREADS;
    float* biasT = (float*)(ws + WS_BIAST); const float* rel = a.in[10];
    for (int i = gt; i < NH * 2048; i += NGT) { const int h = i >> 11, dist = i & 2047; biasT[i] = rel[t5_bucket(dist) * NH + h] * 1.4426950408889634f; }
    float* kmz = (float*)(ws + WS_KMEAN);
    for (int i = gt; i < NB * 8 * 8 * 128; i += NGT) kmz[i] = 0.f;
    float* lb = (float*)(ws + WS_LB); const float* alb = a.in[5];
    for (int i = gt; i < 1024; i += NGT) { lb[i] = 0.f; lb[1024 + i] = 1.f / (1.f + __expf(alb[i] - alb[1024 + i])); }
}

__device__ __forceinline__ void kmean_phase(LAS unsigned char* lds, const bf16_t* QKV, float* kmean, int G, int wg) {
    const int tid = opaque_tid(), cp = tid & 127, rg = tid >> 7;
    LAS float* part = (LAS float*)lds;
    for (int u = wg; u < NB * 8 * 4; u += G) {
        const int cq = u & 3, n = (u >> 2) & 7, b = u >> 5;
        const bf16_t* kp = QKV + ((size_t)b * SEQ + n * 256 + rg * 64) * 3072 + 1024 + cq * 256 + 2 * cp;
        float s0 = 0.f, s1 = 0.f;
#pragma unroll 16
        for (int r = 0; r < 64; ++r) { const unsigned w = *(const unsigned*)(kp + (size_t)r * 3072); s0 += bf2f(w); s1 += bf2f(w >> 16); }
        __syncthreads();
        *(LAS f32x2*)(part + rg * 256 + 2 * cp) = (f32x2){s0, s1};
        __syncthreads();
        if (rg == 0) {
            const f32x2 a0 = *(const LAS f32x2*)(part + 2 * cp), a1 = *(const LAS f32x2*)(part + 256 + 2 * cp), a2 = *(const LAS f32x2*)(part + 512 + 2 * cp), a3 = *(const LAS f32x2*)(part + 768 + 2 * cp);
            const f32x2 m = ((a0 + a1) + (a2 + a3)) * (1.f / 256.f);
            const int c = cq * 256 + 2 * cp, h = c >> 7, d = c & 127;
            *(f32x2*)(kmean + ((size_t)((b * 8 + h) * 8 + n)) * 128 + d) = m;
        }
    }
}

__device__ __forceinline__ void attn_phase(LAS unsigned char* lds, const bf16_t* QKV, const float* kmean, const float* biasT, bf16_t* O, int G, int wg) {
    const int tid = opaque_tid(), lane = tid & 63, wid = tid >> 6, fr = lane & 15, fq = lane >> 4;
    constexpr int KS_OFF = 0, VT_OFF = 64 * 256, VT_STR = 136, STAGE = VT_OFF + 128 * 144, BT_OFF = 3 * STAGE;
    const int LK0 = fr * 256 + ((fq ^ (fr & 3)) << 4) + ((fr >> 2) << 6);
    LAS float* BT = (LAS float*)(lds + BT_OFF);
    for (int u = wg; u < 1024; u += G) {
        const int k4 = u >> 8, w8 = u & 255, half = w8 >> 7, bh = w8 & 127, b = bh >> 3, h = bh & 7;
        const int ob = half ? ((k4 == 0) ? 6 : (k4 == 1) ? 1 : (k4 == 2) ? 4 : 3) : ((k4 == 0) ? 7 : (k4 == 1) ? 0 : (k4 == 2) ? 5 : 2);
        const size_t rowbase = (size_t)b * SEQ;
        __syncthreads();
        u32x4 ka0, ka1, va0, va1;
#define ATT_LOAD(TI) do { const int t2_ = (TI); const bool own2_ = t2_ < 4; const int r2_ = t2_ - 4; const int blk2_ = own2_ ? ob : (r2_ >> 2), kt2_ = own2_ ? t2_ : (r2_ & 3); \
            const int key2_ = blk2_ * 256 + kt2_ * 64; \
            const bf16_t* kp_ = QKV + (rowbase + key2_ + (tid >> 3)) * 3072 + 1024 + h * 128 + (tid & 7) * 16; \
            const bf16_t* vp_ = QKV + (rowbase + key2_ + (tid & 63)) * 3072 + 2048 + h * 128 + (tid >> 6) * 16; \
            ka0 = *(const u32x4*)kp_; ka1 = *(const u32x4*)(kp_ + 8); va0 = *(const u32x4*)vp_; va1 = *(const u32x4*)(vp_ + 8); } while (0)
#define ATT_STAGE(BUF) do { LAS unsigned char* sb_ = lds + (BUF) * STAGE; \
            { LAS unsigned char* dst = sb_ + KS_OFF + (tid >> 3) * 256; const int kx_ = (tid >> 3) & 15, c0_ = (tid & 7) * 2; *(LAS u32x4*)(dst + ((c0_ ^ kx_) << 4)) = ka0; *(LAS u32x4*)(dst + (((c0_ + 1) ^ kx_) << 4)) = ka1; } \
            { LAS unsigned char* dst = sb_ + VT_OFF + ((tid >> 6) * 16) * VT_STR + (tid & 63) * 2; \
              _Pragma("unroll") for (int j = 0; j < 8; ++j) { *(LAS bf16_t*)(dst + j * VT_STR) = (bf16_t)(va0[j >> 1] >> (16 * (j & 1))); *(LAS bf16_t*)(dst + (8 + j) * VT_STR) = (bf16_t)(va1[j >> 1] >> (16 * (j & 1))); } } } while (0)
        ATT_LOAD(0);
        int tl = tid; asm volatile("" : "+v"(tl));
        for (int i = tl; i < 2048; i += NTHREADS) BT[i] = biasT[h * 2048 + i];
        LAS float* KM = (LAS float*)(lds + BT_OFF + 8192);
        if (ob > 3) { for (int i = tl; i < ob * 128; i += NTHREADS) KM[i] = kmean[(size_t)(bh * 8) * 128 + i]; }
        const int tq0 = ob * 256 + wid * 32 + fr;
        bf16x8 qf[2][4];
#pragma unroll
        for (int z = 0; z < 2; ++z) { const bf16_t* qp = QKV + (rowbase + tq0 + 16 * z) * 3072 + h * 128 + fq * 8;
#pragma unroll
            for (int ks = 0; ks < 4; ++ks) qf[z][ks] = *(const bf16x8*)(qp + ks * 32); }
        unsigned selmask[2] = {0u, 0u};
        if (ob <= 3) { selmask[0] = selmask[1] = (1u << ob) - 1u; }
        else {
            float v1[2] = {-INFINITY, -INFINITY}, v2[2] = {-INFINITY, -INFINITY}, v3[2] = {-INFINITY, -INFINITY}; int i1[2] = {0, 0}, i2[2] = {0, 0}, i3[2] = {0, 0};
            LDS_BARRIER();
#pragma unroll 2
            for (int n = 0; n < ob; ++n) {
                const LAS float* km = KM + n * 128 + fq * 8;
                float p0 = 0.f, p1 = 0.f;
#pragma unroll
                for (int ks = 0; ks < 4; ++ks) {
                    const f32x4 k0 = *(const LAS f32x4*)(km + ks * 32), k1 = *(const LAS f32x4*)(km + ks * 32 + 4);
#pragma unroll
                    for (int j = 0; j < 4; ++j) { p0 += bf2f((unsigned short)qf[0][ks][j]) * k0[j]; p0 += bf2f((unsigned short)qf[0][ks][4 + j]) * k1[j];
                                                  p1 += bf2f((unsigned short)qf[1][ks][j]) * k0[j]; p1 += bf2f((unsigned short)qf[1][ks][4 + j]) * k1[j]; }
                }
                p0 += __shfl_xor(p0, 16); p0 += __shfl_xor(p0, 32); p1 += __shfl_xor(p1, 16); p1 += __shfl_xor(p1, 32);
#pragma unroll
                for (int z = 0; z < 2; ++z) { const float p = z ? p1 : p0;
                    if (p > v1[z]) { v3[z] = v2[z]; i3[z] = i2[z]; v2[z] = v1[z]; i2[z] = i1[z]; v1[z] = p; i1[z] = n; }
                    else if (p > v2[z]) { v3[z] = v2[z]; i3[z] = i2[z]; v2[z] = p; i2[z] = n; }
                    else if (p > v3[z]) { v3[z] = p; i3[z] = n; } }
            }
            selmask[0] = (1u << i1[0]) | (1u << i2[0]) | (1u << i3[0]); selmask[1] = (1u << i1[1]) | (1u << i2[1]) | (1u << i3[1]);
        }
        const int nTiles = 4 + ob * 4;
        float m_run[2] = {-1e30f, -1e30f}, l_run[2] = {0.f, 0.f};
        f32x4 oacc[2][8];
#pragma unroll
        for (int z = 0; z < 2; ++z)
#pragma unroll
            for (int e = 0; e < 8; ++e) oacc[z][e] = (f32x4){0.f, 0.f, 0.f, 0.f};
        ATT_STAGE(0);
        ATT_LOAD(1);
        const bool skew = wid >= 4;
        bf16x8 pf[2][2]; bool pend = false; int pend_buf = 0, cur = 0;
#define ATT_PV(SB) do { const LAS unsigned char* sv_ = (SB); __builtin_amdgcn_s_setprio(1); \
            _Pragma("unroll") for (int e = 0; e < 8; ++e) _Pragma("unroll") for (int i = 0; i < 2; ++i) { \
                const LAS unsigned char* vr = sv_ + VT_OFF + (e * 16 + fr) * VT_STR + (32 * i + fq * 4) * 2; \
                const s16x4 lo = *(const LAS s16x4*)vr, hi = *(const LAS s16x4*)(vr + 32); \
                const bf16x8 af = __builtin_shufflevector(lo, hi, 0, 1, 2, 3, 4, 5, 6, 7); \
                oacc[0][e] = MFMA16(af, pf[0][i], oacc[0][e]); oacc[1][e] = MFMA16(af, pf[1][i], oacc[1][e]); \
                if (i == 1 && (e & 1)) __builtin_amdgcn_sched_barrier(0); } __builtin_amdgcn_s_setprio(0); } while (0)
        for (int ti = 0; ti < nTiles; ++ti) {
            const bool own = ti < 4; const int r_ = ti - 4; const int blk = own ? ob : (r_ >> 2), kt = own ? ti : (r_ & 3);
            const int key0 = blk * 256 + kt * 64;
            LDS_BARRIER();
            const int nxt = (cur == 2) ? 0 : cur + 1;
            if (ti + 1 < nTiles) { ATT_STAGE(nxt); if (ti + 2 < nTiles) ATT_LOAD(ti + 2); }
            const LAS unsigned char* sb = lds + cur * STAGE;
            if (pend) { ATT_PV(lds + pend_buf * STAGE); pend = false; }
            const int cur_ = cur; cur = nxt;
            if (own && kt * 64 > wid * 32 + 31) continue;
            f32x4 sc[2][4];
            __builtin_amdgcn_s_setprio(1);
#pragma unroll
            for (int st = 0; st < 4; ++st) { sc[0][st] = (f32x4){0.f, 0.f, 0.f, 0.f}; sc[1][st] = (f32x4){0.f, 0.f, 0.f, 0.f};
#pragma unroll
                for (int ks = 0; ks < 4; ++ks) { const bf16x8 af = *(const LAS bf16x8*)(sb + KS_OFF + st * 4096 + (LK0 ^ (ks << 6)));
                    sc[0][st] = MFMA16(af, qf[0][ks], sc[0][st]); sc[1][st] = MFMA16(af, qf[1][ks], sc[1][st]); }
                __builtin_amdgcn_sched_barrier(0); }
            __builtin_amdgcn_s_setprio(0);
#pragma unroll
            for (int z = 0; z < 2; ++z) {
                const int tq = tq0 + 16 * z;
                const bool selok = (selmask[z] >> blk) & 1u;
                float mx = -1e30f;
                if (own) {
#pragma unroll
                    for (int st = 0; st < 4; ++st)
#pragma unroll
                        for (int j = 0; j < 4; ++j) { const int dist = tq - (key0 + st * 16 + fq * 4 + j);
                            float s = sc[z][st][j] + BT[dist < 0 ? 0 : dist]; s = (dist >= 0) ? s : -1e30f; sc[z][st][j] = s; mx = fmaxf(mx, s); }
                } else {
                    const LAS float* bp = BT + (tq0 - key0 - fq * 4 - 63);
#pragma unroll
                    for (int st = 0; st < 4; ++st)
#pragma unroll
                        for (int j = 0; j < 4; ++j) { const float s = sc[z][st][j] + bp[63 - st * 16 - j + 16 * z]; sc[z][st][j] = s; mx = fmaxf(mx, s); }
                    mx = selok ? mx : -1e30f;
                }
                mx = fmaxf(mx, __shfl_xor(mx, 16)); mx = fmaxf(mx, __shfl_xor(mx, 32));
                const float m_new = fmaxf(m_run[z], mx), alpha = __builtin_amdgcn_exp2f(m_run[z] - m_new); m_run[z] = m_new;
                const float m_sub = (own || selok) ? m_new : 1e30f;
                float ps = 0.f;
#pragma unroll
                for (int st = 0; st < 4; ++st)
#pragma unroll
                    for (int j = 0; j < 4; ++j) { const float p = __builtin_amdgcn_exp2f(sc[z][st][j] - m_sub); sc[z][st][j] = p; ps += p; }
                l_run[z] = l_run[z] * alpha + ps;
                if (__builtin_amdgcn_ballot_w64(alpha != 1.0f) != 0ull) {
#pragma unroll
                    for (int e = 0; e < 8; ++e) oacc[z][e] = oacc[z][e] * alpha;
                }
#pragma unroll
                for (int i = 0; i < 2; ++i) { u32x4 w; w.x = pk2(sc[z][2 * i][0], sc[z][2 * i][1]); w.y = pk2(sc[z][2 * i][2], sc[z][2 * i][3]); w.z = pk2(sc[z][2 * i + 1][0], sc[z][2 * i + 1][1]); w.w = pk2(sc[z][2 * i + 1][2], sc[z][2 * i + 1][3]); pf[z][i] = __builtin_bit_cast(bf16x8, w); }
            }
            if (skew) { pend = true; pend_buf = cur_; } else ATT_PV(sb);
        }
        if (pend) ATT_PV(lds + pend_buf * STAGE);
#undef ATT_PV
#pragma unroll
        for (int z = 0; z < 2; ++z) {
            float l = l_run[z]; l += __shfl_xor(l, 16); l += __shfl_xor(l, 32);
            const float inv = 1.f / l;
            bf16_t* op = O + (rowbase + tq0 + 16 * z) * 1024 + h * 128 + ((fq & 1) ? 16 + (fq - 1) * 4 : fq * 4);
#pragma unroll
            for (int e = 0; e < 8; e += 2) { u32x2 wa, wb; wa.x = pk2(oacc[z][e][0] * inv, oacc[z][e][1] * inv); wa.y = pk2(oacc[z][e][2] * inv, oacc[z][e][3] * inv);
                wb.x = pk2(oacc[z][e + 1][0] * inv, oacc[z][e + 1][1] * inv); wb.y = pk2(oacc[z][e + 1][2] * inv, oacc[z][e + 1][3] * inv);
                *(u32x4*)(op + e * 16) = pair_tiles(wa, wb, fq); }
        }
    }
}

#undef ATT_LOAD
#undef ATT_STAGE
__device__ __forceinline__ void gla_phase(LAS unsigned char* lds, const bf16_t* P, const float* hn, bf16_t* O, int G, int wg) {
    const int tid = opaque_tid(), lane = tid & 63, wid = tid >> 6, fr = lane & 15, fq = lane >> 4;
    constexpr int QT = 0, KT = 16384, ST = 32768, KTT = 65536, VT = 81920, AM = 98304, PART = 106496, SSQX = 110592, HNL = 111104;
    const int LK0 = fr * 256 + ((fq ^ (fr & 3)) << 4) + ((fr >> 2) << 6);
    const int LS0 = fr * 128 + ((fq ^ ((fr >> 1) & 3)) << 4) + ((fr >> 3) << 6);
    constexpr float LOG2E = 1.4426950408889634f;
    const int dp = tid & 63, tq = tid >> 6;
    const int tt = wid & 3, eh = wid >> 2;
#define FRAGK(base, X, ks) (*(const LAS bf16x8*)(lds + (base) + (X) * 4096 + (LK0 ^ ((ks) << 6))))
#define FRAGS(base, X, ks) (*(const LAS bf16x8*)(lds + (base) + (X) * 2048 + (LS0 ^ ((ks) << 6))))
#define GLA_EPILOGUE(CC) do { const int t_ = tt * 16 + fr; const float tot_ = ((LAS float*)(lds + SSQX))[t_] + ((LAS float*)(lds + SSQX))[64 + t_]; \
        const float rstd_ = __builtin_amdgcn_rsqf(tot_ * (1.f / 128.f) + EPS); const size_t row_ = (size_t)b * SEQ + (CC) * 64 + t_; \
        u32x2 wq_[4]; \
        _Pragma("unroll") for (int i = 0; i < 4; ++i) { const int e0 = (eh * 4 + i) * 16 + fq * 4; const u32x2 g = gpre[i]; const f32x4 hv = *(const LAS f32x4*)(lds + HNL + e0 * 4); \
            wq_[i].x = pk2(oacc[i][0] * rstd_ * hv[0] * bf2f(g.x), oacc[i][1] * rstd_ * hv[1] * bf2f(g.x >> 16)); wq_[i].y = pk2(oacc[i][2] * rstd_ * hv[2] * bf2f(g.y), oacc[i][3] * rstd_ * hv[3] * bf2f(g.y >> 16)); } \
        _Pragma("unroll") for (int i = 0; i < 4; i += 2) *(u32x4*)(O + row_ * 1024 + h * 128 + (eh * 4 + i) * 16 + ((fq & 1) ? 16 + (fq - 1) * 4 : fq * 4)) = pair_tiles(wq_[i], wq_[i + 1], fq); } while (0)
#define GLA_GLOAD(CC) do { const size_t row_ = (size_t)b * SEQ + (CC) * 64 + tt * 16 + fr; \
        _Pragma("unroll") for (int i = 0; i < 4; ++i) gpre[i] = *(const u32x2*)(P + row_ * 4096 + 3072 + h * 128 + (eh * 4 + i) * 16 + fq * 4); } while (0)
    for (int unit = wg; unit < NB * NH; unit += G) {
        const int b = unit >> 3, h = unit & 7;
        __syncthreads();
        if (tid < 128) ((LAS float*)(lds + HNL))[tid] = hn[tid];
        f32x4 sacc[8];
#pragma unroll
        for (int e = 0; e < 8; ++e) sacc[e] = (f32x4){0.f, 0.f, 0.f, 0.f};
        const bf16_t* pbase = P + ((size_t)b * SEQ) * 4096 + h * 128 + 2 * dp;
        unsigned rq[8], rl[8], rv[8];
        { const bf16_t* pp = pbase + (size_t)(tq * 8) * 4096;
#pragma unroll
          for (int i = 0; i < 8; ++i) { rq[i] = *(const unsigned*)(pp + (size_t)i * 4096); rl[i] = *(const unsigned*)(pp + (size_t)i * 4096 + 1024); rv[i] = *(const unsigned*)(pp + (size_t)i * 4096 + 2048); } }
        f32x4 oacc[4]; u32x2 gpre[4];
#pragma unroll
        for (int i = 0; i < 4; ++i) { oacc[i] = (f32x4){0.f, 0.f, 0.f, 0.f}; gpre[i] = (u32x2){0u, 0u}; }
        for (int c = 0; c < 32; ++c) {
            float q0[8], q1[8], l0[8], l1[8], b0[8], b1[8]; unsigned vt0[4], vt1[4];
            float run0 = 0.f, run1 = 0.f;
#pragma unroll
            for (int i = 0; i < 8; ++i) { q0[i] = bf2f(rq[i]); q1[i] = bf2f(rq[i] >> 16); l0[i] = bf2f(rl[i]) * LOG2E; l1[i] = bf2f(rl[i] >> 16) * LOG2E; run0 += l0[i]; b0[i] = run0; run1 += l1[i]; b1[i] = run1; }
#pragma unroll
            for (int i = 0; i < 4; ++i) { vt0[i] = (rv[2 * i] & 0xffffu) | (rv[2 * i + 1] << 16); vt1[i] = (rv[2 * i] >> 16) | (rv[2 * i + 1] & 0xffff0000u); }
            { const int cn = (c < 31) ? c + 1 : 31;
              const bf16_t* pp = pbase + (size_t)(cn * 64 + tq * 8) * 4096;
#pragma unroll
                for (int i = 0; i < 8; ++i) { rq[i] = *(const unsigned*)(pp + (size_t)i * 4096); rl[i] = *(const unsigned*)(pp + (size_t)i * 4096 + 1024); rv[i] = *(const unsigned*)(pp + (size_t)i * 4096 + 2048); } }
            *(LAS f32x2*)(lds + PART + (tq * 128 + 2 * dp) * 4) = (f32x2){run0, run1};
            LDS_BARRIER();
            if (c > 0) GLA_EPILOGUE(c - 1);
            GLA_GLOAD(c);
            float off0 = 0.f, off1 = 0.f, bm0 = 0.f, bm1 = 0.f;
#pragma unroll
            for (int s2 = 0; s2 < 4; ++s2) { const f32x2 p = *(const LAS f32x2*)(lds + PART + (s2 * 128 + 2 * dp) * 4); if (s2 < tq) { off0 += p.x; off1 += p.y; } bm0 += p.x; bm1 += p.y; }
#pragma unroll
            for (int s2 = 4; s2 < 7; ++s2) { const f32x2 p = *(const LAS f32x2*)(lds + PART + (s2 * 128 + 2 * dp) * 4); if (s2 < tq) { off0 += p.x; off1 += p.y; } }
            f32x4 cm4;
            { f32x4 bm4 = (f32x4){0.f, 0.f, 0.f, 0.f};
#pragma unroll
              for (int s2 = 0; s2 < 4; ++s2) bm4 += *(const LAS f32x4*)(lds + PART + (s2 * 128 + wid * 16 + fq * 4) * 4);
#pragma unroll
              for (int j = 0; j < 4; ++j) cm4[j] = __builtin_amdgcn_exp2f(bm4[j]); }
#pragma unroll
            for (int e = 0; e < 8; ++e) { const int et = ((e < 4) ? eh : (eh ^ 1)) * 4 + (e & 3);
                u32x2 w; w.x = pk2(sacc[e][0] * cm4[0], sacc[e][1] * cm4[1]); w.y = pk2(sacc[e][2] * cm4[2], sacc[e][3] * cm4[3]);
                *(LAS u32x2*)(lds + ST + (et * 16 + fr) * 256 + (((wid * 2 + (fq >> 1)) ^ fr) << 4) + (fq & 1) * 8) = w; }
            unsigned kt0[4], kt1[4];
#pragma unroll
            for (int i = 0; i < 8; i += 2) {
                float k0v[2], k1v[2];
#pragma unroll
                for (int z = 0; z < 2; ++z) {
                    const int ii = i + z, t = tq * 8 + ii; const float x0 = b0[ii] + off0 - bm0, x1 = b1[ii] + off1 - bm1;
                    const float kv0 = 1.f - __builtin_amdgcn_exp2f(l0[ii]), kv1 = 1.f - __builtin_amdgcn_exp2f(l1[ii]);
                    const float e10 = __builtin_amdgcn_exp2f(fminf(x0, 80.f)), e20 = __builtin_amdgcn_exp2f(fminf(-x0, 80.f));
                    const float e11 = __builtin_amdgcn_exp2f(fminf(x1, 80.f)), e21 = __builtin_amdgcn_exp2f(fminf(-x1, 80.f));
                    k0v[z] = kv0 * e20; k1v[z] = kv1 * e21;
                    const int wo = t * 256 + ((((dp >> 2) ^ (t & 15))) << 4) + (dp & 3) * 4;
                    *(LAS unsigned*)(lds + QT + wo) = pk2(q0[ii] * e10, q1[ii] * e11);
                    *(LAS unsigned*)(lds + KT + wo) = pk2(k0v[z], k1v[z]);
                }
                kt0[i >> 1] = pk2(k0v[0], k0v[1]); kt1[i >> 1] = pk2(k1v[0], k1v[1]);
            }
            { const int so = (2 * dp) * 128 + ((tq ^ (dp & 7)) << 4); constexpr int TS = 128;
              LAS unsigned char* dk = lds + KTT + so; LAS unsigned char* dv = lds + VT + so;
              *(LAS u32x4*)dk = (u32x4){kt0[0], kt0[1], kt0[2], kt0[3]}; *(LAS u32x4*)(dk + TS) = (u32x4){kt1[0], kt1[1], kt1[2], kt1[3]};
              *(LAS u32x4*)dv = (u32x4){vt0[0], vt0[1], vt0[2], vt0[3]}; *(LAS u32x4*)(dv + TS) = (u32x4){vt1[0], vt1[1], vt1[2], vt1[3]}; }
            LDS_BARRIER();
            { const int st = wid & 3, tA = (wid >> 2) * 2;
              bf16x8 kA[4], qA[2][4], qB[4], sB[4][4];
#pragma unroll
              for (int ks = 0; ks < 4; ++ks) { kA[ks] = FRAGK(KT, st, ks); qA[0][ks] = FRAGK(QT, tA, ks); qA[1][ks] = FRAGK(QT, tA + 1, ks); }
#pragma unroll
              for (int ks = 0; ks < 4; ++ks) qB[ks] = FRAGK(QT, tt, ks);
              __builtin_amdgcn_sched_barrier(0);
              f32x4 accA[2];
#pragma unroll
              for (int z = 0; z < 2; ++z) { accA[z] = (f32x4){0.f, 0.f, 0.f, 0.f};
                if (tA + z >= st) {
#pragma unroll
                    for (int ks = 0; ks < 4; ++ks) accA[z] = MFMA16(kA[ks], qA[z][ks], accA[z]);
                } }
              __builtin_amdgcn_sched_barrier(0);
#pragma unroll
              for (int i = 0; i < 4; ++i)
#pragma unroll
                for (int ks = 0; ks < 4; ++ks) sB[i][ks] = FRAGK(ST, eh * 4 + i, ks);
              __builtin_amdgcn_sched_barrier(0);
#pragma unroll
              for (int z = 0; z < 2; ++z) { const int t = (tA + z) * 16 + fr, s0_ = st * 16 + fq * 4;
                u32x2 w; w.x = pk2(t >= s0_ ? accA[z][0] : 0.f, t >= s0_ + 1 ? accA[z][1] : 0.f); w.y = pk2(t >= s0_ + 2 ? accA[z][2] : 0.f, t >= s0_ + 3 ? accA[z][3] : 0.f);
                *(LAS u32x2*)(lds + AM + t * 128 + ((((st * 2 + (fq >> 1))) ^ ((fr >> 1) & 7)) << 4) + (fq & 1) * 8) = w; }
#pragma unroll
              for (int i = 0; i < 4; ++i) { oacc[i] = (f32x4){0.f, 0.f, 0.f, 0.f};
#pragma unroll
                for (int ks = 0; ks < 4; ++ks) oacc[i] = MFMA16(sB[i][ks], qB[ks], oacc[i]); }
            }
            LDS_BARRIER();
            { bf16x8 aM[2], vO[4][2], kD[2], vX[4][2];
#pragma unroll
              for (int ks = 0; ks < 2; ++ks) { aM[ks] = FRAGS(AM, tt, ks);
#pragma unroll
                for (int i = 0; i < 4; ++i) vO[i][ks] = FRAGS(VT, eh * 4 + i, ks); }
              __builtin_amdgcn_sched_barrier(0);
#pragma unroll
              for (int ks = 0; ks < 2; ++ks) { kD[ks] = FRAGS(KTT, wid, ks);
#pragma unroll
                for (int i = 0; i < 4; ++i) vX[i][ks] = FRAGS(VT, (eh ^ 1) * 4 + i, ks); }
#pragma unroll
              for (int i = 0; i < 4; ++i)
#pragma unroll
                for (int ks = 0; ks < 2; ++ks) oacc[i] = MFMA16(vO[i][ks], aM[ks], oacc[i]);
              __builtin_amdgcn_sched_barrier(0);
              f32x4 dec4, cl4;
              { f32x4 bm4 = (f32x4){0.f, 0.f, 0.f, 0.f}, bl4 = (f32x4){0.f, 0.f, 0.f, 0.f};
#pragma unroll
                for (int s2 = 0; s2 < 8; ++s2) { const f32x4 p = *(const LAS f32x4*)(lds + PART + (s2 * 128 + wid * 16 + fq * 4) * 4); if (s2 < 4) bm4 += p; bl4 += p; }
#pragma unroll
                for (int j = 0; j < 4; ++j) { dec4[j] = __builtin_amdgcn_exp2f(bl4[j]); cl4[j] = __builtin_amdgcn_exp2f(bl4[j] - bm4[j]); } }
#pragma unroll
              for (int e = 0; e < 8; ++e) { f32x4 tmp = (f32x4){0.f, 0.f, 0.f, 0.f};
#pragma unroll
                for (int ks = 0; ks < 2; ++ks) tmp = MFMA16(kD[ks], (e < 4) ? vO[e & 3][ks] : vX[e & 3][ks], tmp);
                sacc[e] = sacc[e] * dec4 + tmp * cl4; }
            }
            { float s = 0.f;
#pragma unroll
              for (int i = 0; i < 4; ++i) s += (oacc[i][0] * oacc[i][0] + oacc[i][1] * oacc[i][1]) + (oacc[i][2] * oacc[i][2] + oacc[i][3] * oacc[i][3]);
              s += __shfl_xor(s, 16); s += __shfl_xor(s, 32);
              if (fq == 0) ((LAS float*)(lds + SSQX))[eh * 64 + tt * 16 + fr] = s; }
        }
        __syncthreads();
        GLA_EPILOGUE(31);
    }
#undef FRAGK
#undef FRAGS
#undef GLA_EPILOGUE
#undef GLA_GLOAD
}

__device__ __forceinline__ f32x2 ldx2(const bf16_t* p) { const unsigned w = *(const unsigned*)p; return (f32x2){__builtin_bit_cast(float, w << 16), __builtin_bit_cast(float, w & 0xffff0000u)}; }
template <int W> __device__ __forceinline__ void pool_unit(const bf16_t* x, const LAS float* rs, f32x2 gn, bf16_t* Ag, size_t rb, int t0, int c, int g) {
    f32x2 ring[16], hn_[16];
#pragma unroll
    for (int i = 0; i < 16; ++i) { const int t = t0 - 16 + i; ring[i] = (t >= 0) ? ldx2(x + (rb + t) * 1024 + c) * rs[i] * gn : (f32x2){0.f, 0.f}; }
    f32x2 win = (f32x2){0.f, 0.f};
#pragma unroll
    for (int i = 16 - (W - 1); i < 16; ++i) win += ring[i];
#pragma unroll
    for (int bt = 0; bt < 4; ++bt) {
#pragma unroll
        for (int i = 0; i < 16; ++i) hn_[i] = ldx2(x + (rb + t0 + bt * 16 + i) * 1024 + c) * rs[16 + bt * 16 + i] * gn;
#pragma unroll
        for (int i = 0; i < 16; ++i) { const int t = t0 + bt * 16 + i;
            win += hn_[i]; const float inv = 1.f / (float)((t + 1) < W ? (t + 1) : W);
            const f32x2 a = win * inv - hn_[i];
            *(unsigned*)(Ag + ((size_t)g * MT + rb + t) * 256 + (c & 255)) = pk2(a.x, a.y);
            win -= (i - W + 1 >= 0) ? hn_[(i - W + 1 >= 0) ? (i - W + 1) : 0] : ring[(i - W + 17) & 15]; }
#pragma unroll
        for (int i = 0; i < 16; ++i) ring[i] = hn_[i];
    }
}
__device__ __forceinline__ void pool_phase(LAS unsigned char* lds, const bf16_t* x, const float* ssq, const float* gain, bf16_t* Ag, int G, int wg) {
    const int tid = opaque_tid(); const int c = 2 * tid, g = c >> 8;
    const f32x2 gn = *(const f32x2*)(gain + c);
    LAS float* rs = (LAS float*)lds;
    for (int u = wg; u < NB * 32; u += G) {
        const int b = u >> 5, t0 = (u & 31) * 64; const size_t rb = (size_t)b * SEQ;
        __syncthreads();
        if (tid < 80) { const int t = t0 - 16 + tid; rs[tid] = (t >= 0) ? __builtin_amdgcn_rsqf(pg8::ssq_row(ssq, (int)(rb + t)) * (1.f / 1024.f) + EPS) : 0.f; }
        __syncthreads();
        if (g == 0) pool_unit<2>(x, rs, gn, Ag, rb, t0, c, g); else if (g == 1) pool_unit<4>(x, rs, gn, Ag, rb, t0, c, g);
        else if (g == 2) pool_unit<8>(x, rs, gn, Ag, rb, t0, c, g); else pool_unit<16>(x, rs, gn, Ag, rb, t0, c, g);
    }
}

__device__ __forceinline__ void final_phase(const bf16_t* xb, float* out, const float* ssq, const float* gain, int G, int wg) {
    const int tid = opaque_tid(), lane = tid & 63, wave = tid >> 6; const int gw = wg * 8 + wave, NGW = G * 8;
    f32x4 gv[4];
#pragma unroll
    for (int j = 0; j < 4; ++j) gv[j] = ((const f32x4*)gain)[lane + 64 * j];
    for (int m0 = gw; m0 < MT; m0 += 4 * NGW) {
        u32x2 w[4][4]; float ss[4];
#pragma unroll
        for (int q = 0; q < 4; ++q) { const int m = m0 + q * NGW, mc = m < MT ? m : m0; ss[q] = pg8::ssq_row(ssq, mc);
            const u32x2* xr = (const u32x2*)(xb + (size_t)mc * DM) + lane;
#pragma unroll
            for (int j = 0; j < 4; ++j) w[q][j] = xr[64 * j]; }
#pragma unroll
        for (int q = 0; q < 4; ++q) { const int m = m0 + q * NGW; if (m >= MT) break;
            const float rs = __builtin_amdgcn_rsqf(ss[q] * (1.f / 1024.f) + EPS);
            f32x4* orow = (f32x4*)(out + (size_t)m * DM) + lane;
#pragma unroll
            for (int j = 0; j < 4; ++j) { const u32x2 ww = w[q][j];
                const f32x4 v = {__builtin_bit_cast(float, ww.x << 16), __builtin_bit_cast(float, ww.x & 0xffff0000u), __builtin_bit_cast(float, ww.y << 16), __builtin_bit_cast(float, ww.y & 0xffff0000u)};
                orow[64 * j] = v * rs * gv[j]; } }
    }
}

#define XB_TMO      128
#define XB_XCNT(j)  (256  + 64 * (j))
#define XB_XSUB(j)  (1280 + 64 * (j))
#define XB_XGEN(j)  (2304 + 64 * (j))
#define XB_TOP      3328
#define XB_TOPGEN   3392
#define XCD_BAR_WORDS 3456
#define XB_SPIN_CAP (1u << 18)

__device__ __forceinline__ unsigned xb_ld(unsigned* p)              { return __hip_atomic_load(p, __ATOMIC_RELAXED, __HIP_MEMORY_SCOPE_AGENT); }
__device__ __forceinline__ unsigned xb_add(unsigned* p, unsigned v) { return __hip_atomic_fetch_add(p, v, __ATOMIC_RELAXED, __HIP_MEMORY_SCOPE_AGENT); }
__device__ __forceinline__ unsigned xb_xcc_id() { return (unsigned)__builtin_amdgcn_s_getreg((3 << 11) | 20) & 0xFu; }
#define XB_SPIN(cond, bar) do { unsigned _sp = 0; while (cond) { __builtin_amdgcn_s_sleep(1); \
    if ((++_sp & 255u) == 0u) { if (xb_ld(&(bar)[XB_TMO])) break; if (_sp > XB_SPIN_CAP) { atomicAdd(&(bar)[XB_TMO], 1u); break; } } } } while (0)

struct XcdBarrier {
    unsigned* bar; unsigned x;
    volatile LAS unsigned* st;
};

__device__ __forceinline__ XcdBarrier xcd_barrier_post(unsigned* bar, volatile LAS unsigned* st) {
    XcdBarrier b; b.bar = bar; b.x = xb_xcc_id(); b.st = st;
    if (threadIdx.x == 0) (void)xb_add(&bar[XB_XCNT(b.x)], 1u);
    return b;
}
__device__ __forceinline__ void xcd_barrier_complete(unsigned* bar, unsigned x, unsigned& nloc, unsigned& nx) {
    const unsigned G = gridDim.x * gridDim.y * gridDim.z;
    unsigned sum, cnt, mine, sp = 0u;
    for (;;) {
        sum = 0u; cnt = 0u; mine = 0u;
#pragma unroll
        for (unsigned j = 0; j < 16; ++j) { const unsigned c = xb_ld(&bar[XB_XCNT(j)]); sum += c; cnt += (c > 0u) ? 1u : 0u; mine = (j == x) ? c : mine; }
        if (sum == G) break;
        __builtin_amdgcn_s_sleep(1);
        if ((++sp & 255u) == 0u) { if (xb_ld(&bar[XB_TMO])) break; if (sp > XB_SPIN_CAP) { atomicAdd(&bar[XB_TMO], 1u); break; } }
    }
    nloc = mine > 0u ? mine : 1u; nx = cnt > 0u ? cnt : 1u;
}

__device__ __forceinline__ void xcd_barrier(const XcdBarrier& b) {
    asm volatile("s_waitcnt vmcnt(0)" ::: "memory");
    __syncthreads();
    if (threadIdx.x == 0) {
        unsigned* bar = b.bar;
        __builtin_amdgcn_s_waitcnt(0);
        unsigned nloc = b.st[0], nx = b.st[1];
        if (nloc == 0u) { xcd_barrier_complete(bar, b.x, nloc, nx); b.st[0] = nloc; b.st[1] = nx; }
        const unsigned old = xb_add(&bar[XB_XSUB(b.x)], 1u);
        const unsigned gen = old / nloc;
        if (old + 1u == (gen + 1u) * nloc) {
            __builtin_amdgcn_fence(__ATOMIC_RELEASE, "agent");
            asm volatile("s_waitcnt vmcnt(0)" ::: "memory");
            const unsigned og = xb_add(&bar[XB_TOP], 1u);
            const unsigned tg = og / nx;
            if (og + 1u == (tg + 1u) * nx) xb_add(&bar[XB_TOPGEN], 1u);
            else XB_SPIN(xb_ld(&bar[XB_TOPGEN]) == tg, bar);
            __builtin_amdgcn_fence(__ATOMIC_ACQUIRE, "agent");
            xb_add(&bar[XB_XGEN(b.x)], 1u);
            asm volatile("s_waitcnt vmcnt(0)" ::: "memory");
        } else {
            XB_SPIN(xb_ld(&bar[XB_XGEN(b.x)]) == gen, bar);
            __builtin_amdgcn_fence(__ATOMIC_ACQUIRE, "agent");
            asm volatile("s_waitcnt vmcnt(0)" ::: "memory");
        }
    }
    __syncthreads();
}

template <class Sched> __device__ __forceinline__ bool build_rstd_table(LAS unsigned char* lds, const Sched& S, const float* ssq) {
    const int tid = opaque_tid(), i = tid >> 6, r0 = tid & 63;
    pg8::Unit uu;
    if (S.next(8, uu)) return false;
    LAS float* tab = (LAS float*)(lds + pg8::RSTD_TAB);
    if (S.next(i, uu)) {
#pragma unroll
        for (int k = 0; k < 4; ++k) tab[i * 256 + r0 + 64 * k] = __builtin_amdgcn_rsqf(pg8::ssq_row(ssq, uu.pm * 256 + r0 + 64 * k) * (1.0f / 1024.0f) + EPS);
    }
    __syncthreads();
    return true;
}

constexpr int NPHASES = 21;
#ifndef REP_P0
#define REP_P0 1
#endif
#ifndef REP_GLA
#define REP_GLA 1
#endif
#ifndef REP_ATTN
#define REP_ATTN 1
#endif
#ifndef REP_POOL
#define REP_POOL 1
#endif
#ifndef REP_G3
#define REP_G3 1
#endif
#ifndef REP_G1
#define REP_G1 1
#endif
#ifndef REP_KMEAN
#define REP_KMEAN 1
#endif
#ifndef EXTRA_SYNCS
#define EXTRA_SYNCS 0
#endif
#ifndef REP_G2
#define REP_G2 1
#endif
#ifndef REP_CONV
#define REP_CONV 1
#endif
#ifndef REP_G4
#define REP_G4 1
#endif
__global__ void __launch_bounds__(NTHREADS, 2) fwd_kernel(Args a) {
    extern __shared__ __attribute__((aligned(16))) unsigned char lds_raw[];
    LAS unsigned char* lds = (LAS unsigned char*)lds_raw;
    cg::grid_group grid = cg::this_grid();
    const int G = gridDim.x, wg = blockIdx.x;
    unsigned char* ws = a.ws;
    float* ssqA = (float*)(ws + WS_SSQ); float* ssqB = (float*)(ws + WS_SSQ1);
    bf16_t* XB = (bf16_t*)(ws + WS_XB); bf16_t* O2 = (bf16_t*)(ws + WS_O2); bf16_t* BIG = (bf16_t*)(ws + WS_BIG);
    const int lo = a.ph_lo, hi = a.ph_hi;
    int pid = 0;
    if (threadIdx.x < 16) ((LAS unsigned*)(lds + LDS_BARST))[threadIdx.x] = 0u;
    __syncthreads();
    if (lo > hi) grid.sync();
    XcdBarrier bar = xcd_barrier_post((unsigned*)(ws + WS_BAR), (volatile LAS unsigned*)(lds + LDS_BARST));
#define PH_BEGIN if (pid >= lo && pid < hi) {
#define PH_END   if (pid + 1 < hi) xcd_barrier(bar); } ++pid;

    PH_BEGIN
for (int rep = 0; rep < REP_P0; ++rep) { p0_phase(a, lds, G, wg, 0, G >= 256); __syncthreads(); }
    for (int rep = 0; rep < EXTRA_SYNCS; ++rep) xcd_barrier(bar);
 PH_END

    for (int i = 0; i < DEPTH; ++i) {
        const int mixer = i % 3, j = i / 3;
        if (mixer != 2) {
            PH_BEGIN
            pg8::Gemm g; pg8::EpiAct E;
            if (mixer == 0) { g = pg8::Gemm{XB, (const bf16_t*)(ws + WS_AWIN) + (size_t)j * 4096 * DM, MT, 4096, DM, 0}; E = pg8::EpiAct{BIG, 4096, ssqA, 0, (const float*)(ws + WS_LB) + j * 1024, 1.f, nullptr, 0}; }
            else { g = pg8::Gemm{XB, (const bf16_t*)(ws + WS_BQKV), MT, 3072, DM, 0}; E = pg8::EpiAct{BIG, 3072, ssqA, 1, nullptr, 0.08838834764831845f * 1.4426950408889634f, (float*)(ws + WS_KMEAN), 0}; }
            pg8::StaticOrder S; S.init(g.M, g.N, G, wg);
            E.use_tab = build_rstd_table(lds, S, E.ssq) ? 1 : 0;
            for (int rep = 0; rep < REP_G1; ++rep) pg8::gemm_phase<pg8::EpiAct, pg8::StaticOrder, true, true>(lds, g, S, E);

            PH_END
        } else {
            PH_BEGIN for (int rep = 0; rep < REP_POOL; ++rep) pool_phase(lds, XB, ssqA, a.in[1] + i * DM, O2, G, wg); PH_END
        }
        if (mixer == 0) {
            PH_BEGIN
if ((i == 0 || i == 3) && G >= 256 && wg >= 128) { for (int rep = 0; rep < REP_CONV; ++rep) p0_phase(a, lds, G - 128, wg - 128, i == 0 ? 1 : 2, true); }
            else for (int rep = 0; rep < REP_GLA; ++rep) gla_phase(lds, BIG, a.in[6] + j * 128, O2, G, wg);
 PH_END
        } else if (mixer == 1) {
            PH_BEGIN
for (int rep = 0; rep < REP_ATTN; ++rep) attn_phase(lds, BIG, (const float*)(ws + WS_KMEAN), (const float*)(ws + WS_BIAST), O2, G, wg);
 PH_END
        }
        {
            PH_BEGIN
            pg8::Gemm g;
            if (mixer == 0) g = pg8::Gemm{O2, (const bf16_t*)(ws + WS_AWOUT) + (size_t)j * DM * DM, MT, DM, DM, 0};
            else if (mixer == 1) g = pg8::Gemm{O2, (const bf16_t*)(ws + WS_BOUT), MT, DM, DM, 0};
            else g = pg8::Gemm{O2, (const bf16_t*)(ws + WS_CW), MT, DM, 256, (size_t)MT * 256 * 2};
            pg8::EpiRes E{XB, ssqB, mixer == 2 ? a.in[12] + j * DM : nullptr, 0};
            pg8::StaticOrder S; S.init(g.M, g.N, G, wg);
            for (int rep = 1; rep < REP_G2; ++rep) { pg8::EpiRes Ed = E; Ed.dry = 1; pg8::gemm_phase<pg8::EpiRes, pg8::StaticOrder, true, true>(lds, g, S, Ed); }
            pg8::gemm_phase<pg8::EpiRes,  pg8::StaticOrder, true, true>(lds, g, S, E);

            PH_END
        }
        {
            PH_BEGIN
            pg8::Gemm g{XB, (const bf16_t*)(ws + WS_W1) + (size_t)i * FF * DM, MT, FF, DM, 0};
            pg8::EpiAct E{BIG, FF, ssqB, 2, nullptr, 1.f, nullptr, 0};
            pg8::StaticOrder S; S.init(g.M, g.N, G, wg);
            E.use_tab = build_rstd_table(lds, S, E.ssq) ? 1 : 0;
            for (int rep = 0; rep < REP_G3; ++rep) pg8::gemm_phase<pg8::EpiAct, pg8::StaticOrder, true, true>(lds, g, S, E);

            PH_END
        }
        {
            PH_BEGIN
            pg8::Gemm g{BIG, (const bf16_t*)(ws + WS_W2) + (size_t)i * DM * FF, MT, DM, FF, 0};
            pg8::EpiRes E{XB, ssqA, nullptr, 0};
            pg8::StaticOrder S; S.init(g.M, g.N, G, wg);
            for (int rep = 1; rep < REP_G4; ++rep) { pg8::EpiRes Ed = E; Ed.dry = 1; pg8::gemm_phase<pg8::EpiRes, pg8::StaticOrder, true, true>(lds, g, S, Ed); }
            pg8::gemm_phase<pg8::EpiRes, pg8::StaticOrder, true, true>(lds, g, S, E);

            PH_END
        }
    }
    PH_BEGIN final_phase(XB, a.out, ssqA, a.in[3], G, wg); PH_END
#undef PH_BEGIN
#undef PH_END
}

extern "C" void kernel_launch(void* const* d_in, const int* in_sizes, int n_in, void* d_out, int out_size, void* d_ws, size_t ws_size, hipStream_t stream) {
    static int grid = 0;
    if (grid == 0) {
        if (n_in != 15 || in_sizes[0] != MT * DM || out_size != MT * DM || ws_size < WS_END) { fprintf(stderr, "kernel_launch: unexpected shapes (n_in %d, in0 %d, out %d, ws %zu need %zu)\n", n_in, n_in > 0 ? in_sizes[0] : -1, out_size, ws_size, (size_t)WS_END); grid = -1; return; }
        int dev = 0, cus = 0, per_cu = 0;
        hipGetDevice(&dev); hipDeviceGetAttribute(&cus, hipDeviceAttributeMultiprocessorCount, dev);
        hipFuncSetAttribute((const void*)fwd_kernel, hipFuncAttributeMaxDynamicSharedMemorySize, LDS_BYTES);
        hipOccupancyMaxActiveBlocksPerMultiprocessor(&per_cu, (const void*)fwd_kernel, NTHREADS, LDS_BYTES);
        (void)hipGetLastError();
        if (per_cu < 1) per_cu = 1;
        grid = cus * per_cu;
        fprintf(stderr, "kernel_launch: grid %d (cus %d x %d)\n", grid, cus, per_cu);
    }
    if (grid < 0) return;
    Args a{};
    for (int i = 0; i < 15; ++i) a.in[i] = (const float*)d_in[i];
    a.out = (float*)d_out; a.ws = (unsigned char*)d_ws;
#if ONE_LAUNCH
    hipMemsetAsync((char*)d_ws + WS_BAR, 0, 16384, stream);
    a.ph_lo = 0; a.ph_hi = NPHASES;
    void* args[] = {&a};
    hipError_t e = hipLaunchCooperativeKernel((const void*)fwd_kernel, dim3(grid), dim3(NTHREADS), args, LDS_BYTES, stream);
    if (e != hipSuccess) fprintf(stderr, "cooperative launch failed: %s (grid %d)\n", hipGetErrorString(e), grid);
#else
    for (int p = 0; p < NPHASES; ++p) {
        a.ph_lo = p; a.ph_hi = p + 1;
        hipLaunchKernelGGL(fwd_kernel, dim3(grid), dim3(NTHREADS), LDS_BYTES, stream, a);
    }
#endif
}
```

```cpp
#include <hip/hip_runtime.h>
#include <hip/hip_cooperative_groups.h>
#include <cstdio>
#include <cstdint>
namespace cg = cooperative_groups;

#ifndef ONE_LAUNCH
#define ONE_LAUNCH 1
#endif

__device__ __forceinline__ int opaque_tid() { int t = threadIdx.x; asm volatile("" : "+v"(t)); return t; }
namespace pg8 {
#define PG8_LAS __attribute__((address_space(3)))
typedef unsigned short bf16_t;
typedef short bf16x8 __attribute__((ext_vector_type(8)));
typedef float f32x4 __attribute__((ext_vector_type(4)));
typedef unsigned u32x4 __attribute__((ext_vector_type(4)));
typedef unsigned u32x2 __attribute__((ext_vector_type(2)));
constexpr int BM = 256, BK = 64, HALF = 128, HTB = HALF * BK * 2  , STAGE_BYTES = 8 * HTB, NXCD = 8, WGM = 8;

__host__ __device__ __forceinline__ int lds_byte(int r, int c) { const int st = (r >> 4) * 2 + (c >> 5), rr = r & 15, cc = c & 31, ob = rr * 64 + cc * 2; return st * 1024 + (ob ^ (((ob >> 9) & 1) << 5)); }
__host__ __device__ __forceinline__ void stage_rc(int b, int& R, int& C) { const int st = b / 1024, sb = b % 1024, swz = sb ^ (((sb >> 9) & 1) << 5); R = (st >> 1) * 16 + swz / 64; C = (st & 1) * 32 + (swz % 64) / 2; }
__host__ __device__ __forceinline__ int perm32(int rho) { const int n = rho >> 4, i = rho & 15; return 8 * (i >> 2) + 4 * n + (i & 3); }

struct Unit { int pm, pn; };
struct Gemm { const bf16_t* A; const bf16_t* Bt; int M, N, K; size_t a_gs; };

struct StaticOrder {
    int nM, nN, nwg, G, c;
    __host__ __device__ void init(int M, int N, int G_, int c_) { nM = M / BM; nN = N / BM; nwg = nM * nN; G = G_; c = c_; }
    __host__ __device__ bool next(int i, Unit& u) const {
        const long L = (long)i * G + c; if (L >= nwg) return false;
        int wgid = (int)L; { const int q = nwg / NXCD, r = nwg % NXCD, xcd = wgid % NXCD, off = wgid / NXCD; wgid = (xcd < r ? xcd * (q + 1) : r * (q + 1) + (xcd - r) * q) + off; }
        const int nig = WGM * nN, gid = wgid / nig, fm = gid * WGM, gsz = (nM - fm) < WGM ? (nM - fm) : WGM;
        u.pm = fm + ((wgid % nig) % gsz); u.pn = (wgid % nig) / gsz; return true;
    }
    __device__ __forceinline__ void a_ready(const Unit&) const {}
    __device__ __forceinline__ void done(const Unit&) const {}
};

__device__ __forceinline__ unsigned cvt_pk_bf16(float lo, float hi) { unsigned r; asm volatile("v_cvt_pk_bf16_f32 %0, %1, %2" : "=v"(r) : "v"(lo), "v"(hi)); return r; }

constexpr float RMS_EPS = 1e-6f;
constexpr int RSTD_TAB = STAGE_BYTES;
__device__ __forceinline__ float ssq_row(const float* part, int row) {
    const f32x4* p = (const f32x4*)(part + (size_t)row * 16);
    const f32x4 a = p[0], b = p[1], c = p[2], d = p[3];
    return (((a[0] + a[1]) + (a[2] + a[3])) + ((b[0] + b[1]) + (b[2] + b[3]))) + (((c[0] + c[1]) + (c[2] + c[3])) + ((d[0] + d[1]) + (d[2] + d[3])));
}
__device__ __forceinline__ float silu_f(float v) { return v * __builtin_amdgcn_rcpf(1.f + __expf(-v)); }

struct EpiAct {
    static constexpr bool PERM = true, AFTER_DRAIN = false;
    bf16_t* O; int ldc; const float* ssq; int mode; const float* lb; float qscale; float* kmean; int use_tab;
    __device__ __forceinline__ void operator()(const f32x4 (&acc)[2][2][4][2], const Unit& u, int wr, int wc, int fr, int fq, int ui, PG8_LAS unsigned char* lds) const {
        const int row0 = u.pm * BM + wr * 64 + fr, col0 = u.pn * BM + wc * 32 + 8 * fq;
        const PG8_LAS float* tab = (const PG8_LAS float*)(lds + RSTD_TAB) + ui * 256 + wr * 64 + fr;
        const int sec = (u.pn * BM) >> 10;
        int act = 0; float sc = 1.f;
        if (mode == 0) act = (sec == 0 || sec == 3) ? 1 : (sec == 1 ? 2 : 0);
        else if (mode == 1) sc = (sec == 0) ? qscale : 1.f;
        else act = 3;
        const bool ksum = (mode == 1) && (sec == 1);
        f32x4 csum[2][2] = {{(f32x4){0.f, 0.f, 0.f, 0.f}, (f32x4){0.f, 0.f, 0.f, 0.f}}, {(f32x4){0.f, 0.f, 0.f, 0.f}, (f32x4){0.f, 0.f, 0.f, 0.f}}};
#pragma unroll
        for (int ai = 0; ai < 2; ++ai) {
            float rs4[4];
#pragma unroll
            for (int m = 0; m < 4; ++m) {
                if ((m & 1) == 0) {
                    if (use_tab) { rs4[m] = tab[ai * HALF + m * 16] * sc; rs4[m + 1] = tab[ai * HALF + (m + 1) * 16] * sc; }
                    else {
                        asm volatile("" ::: "memory");
                        rs4[m] = __builtin_amdgcn_rsqf(ssq_row(ssq, row0 + ai * HALF + m * 16) * (1.0f / 1024.0f) + RMS_EPS) * sc;
                        rs4[m + 1] = __builtin_amdgcn_rsqf(ssq_row(ssq, row0 + ai * HALF + (m + 1) * 16) * (1.0f / 1024.0f) + RMS_EPS) * sc;
                    }
                }
                const int row = row0 + ai * HALF + m * 16;
                const float rs = rs4[m];
                bf16_t* rowp = O + (size_t)row * ldc + col0;
#pragma unroll
                for (int bj = 0; bj < 2; ++bj) {
                    f32x4 v[2] = {acc[ai][bj][m][0] * rs, acc[ai][bj][m][1] * rs};
                    if (ksum) { csum[bj][0] += v[0]; csum[bj][1] += v[1]; }
#pragma unroll
                    for (int n = 0; n < 2; ++n) {
                        f32x4 lbv = (f32x4){0.f, 0.f, 0.f, 0.f};
                        if (act == 2) lbv = *(const f32x4*)(lb + (col0 - 1024) + bj * HALF + 4 * n);
#pragma unroll
                        for (int e = 0; e < 4; ++e) {
                            float x = v[n][e];
                            if (act == 1) x = silu_f(x);
                            else if (act == 2) { const float l = lbv[e]; x = __logf(l + (1.f - l) * __builtin_amdgcn_rcpf(1.f + __expf(-x))); }
                            else if (act == 3) { x = fmaxf(x, 0.f); x = x * x; }
                            v[n][e] = x;
                        }
                    }
                    u32x4 w; w.x = cvt_pk_bf16(v[0][0], v[0][1]); w.y = cvt_pk_bf16(v[0][2], v[0][3]); w.z = cvt_pk_bf16(v[1][0], v[1][1]); w.w = cvt_pk_bf16(v[1][2], v[1][3]);
                    *(u32x4*)(rowp + bj * HALF) = w;
                }
            }
        }
        if (ksum) {
            const int b = u.pm >> 3, nblk = u.pm & 7;
#pragma unroll
            for (int bj = 0; bj < 2; ++bj)
#pragma unroll
                for (int n = 0; n < 2; ++n)
#pragma unroll
                    for (int e = 0; e < 4; ++e) {
                        float t = csum[bj][n][e];
                        t += __shfl_xor(t, 1); t += __shfl_xor(t, 2); t += __shfl_xor(t, 4); t += __shfl_xor(t, 8);
                        if (fr == 0) { const int kc = col0 + bj * HALF + 4 * n + e - 1024, h = kc >> 7, d = kc & 127;
                            atomicAdd(kmean + ((size_t)((b * 8 + h) * 8 + nblk)) * 128 + d, t * (1.0f / 256.0f)); }
                    }
        }
    }
};

struct EpiRes {
    static constexpr bool PERM = true, AFTER_DRAIN = false;
    bf16_t* xb; float* ssq_next; const float* cscale; int dry;
    __device__ __forceinline__ void operator()(const f32x4 (&acc)[2][2][4][2], const Unit& u, int wr, int wc, int fr, int fq, int, PG8_LAS unsigned char*) const {
        const int row0 = u.pm * BM + wr * 64 + fr, col0 = u.pn * BM + wc * 32 + 8 * fq;
        f32x4 csv[2][2];
#pragma unroll
        for (int bj = 0; bj < 2; ++bj)
#pragma unroll
            for (int n = 0; n < 2; ++n) { csv[bj][n] = (f32x4){1.f, 1.f, 1.f, 1.f}; if (cscale) csv[bj][n] = *(const f32x4*)(cscale + col0 + bj * HALF + 4 * n); }
#pragma unroll
        for (int ai = 0; ai < 2; ++ai) {
            u32x4 xw[4][2];
#pragma unroll
            for (int m = 0; m < 4; ++m)
#pragma unroll
                for (int bj = 0; bj < 2; ++bj) xw[m][bj] = *(const u32x4*)(xb + (size_t)(row0 + ai * HALF + m * 16) * 1024 + col0 + bj * HALF);
#pragma unroll
            for (int m = 0; m < 4; ++m) {
                const int row = row0 + ai * HALF + m * 16; const size_t off = (size_t)row * 1024 + col0;
                float s = 0.f;
#pragma unroll
                for (int bj = 0; bj < 2; ++bj) {
                    const u32x4 xv = xw[m][bj];
                    const f32x4 xo0 = {__builtin_bit_cast(float, xv.x << 16), __builtin_bit_cast(float, xv.x & 0xffff0000u), __builtin_bit_cast(float, xv.y << 16), __builtin_bit_cast(float, xv.y & 0xffff0000u)};
                    const f32x4 xo1 = {__builtin_bit_cast(float, xv.z << 16), __builtin_bit_cast(float, xv.z & 0xffff0000u), __builtin_bit_cast(float, xv.w << 16), __builtin_bit_cast(float, xv.w & 0xffff0000u)};
                    const f32x4 o0 = xo0 + acc[ai][bj][m][0] * csv[bj][0], o1 = xo1 + acc[ai][bj][m][1] * csv[bj][1];
                    u32x4 w; w.x = cvt_pk_bf16(o0[0], o0[1]); w.y = cvt_pk_bf16(o0[2], o0[3]); w.z = cvt_pk_bf16(o1[0], o1[1]); w.w = cvt_pk_bf16(o1[2], o1[3]);
                    if (!dry) *(u32x4*)(xb + off + bj * HALF) = w;
#pragma unroll
                    for (int q = 0; q < 4; ++q) { const unsigned ww = w[q]; const float ra = __builtin_bit_cast(float, ww << 16), rb = __builtin_bit_cast(float, ww & 0xffff0000u); s += ra * ra + rb * rb; }
                }
                s += __shfl_xor(s, 16); s += __shfl_xor(s, 32);
                if (fq == 0 && !dry) ssq_next[(size_t)row * 16 + u.pn * 4 + wc] = s;
            }
            asm volatile("" ::: "memory");
        }
    }
};

template <class Epi, class Sched, bool ALIGN_EPI = false, bool SP2 = false>
__device__ __forceinline__ void gemm_phase(PG8_LAS unsigned char* lds, const Gemm g, const Sched& S, const Epi& E) {
    const int tid = opaque_tid(), wid = __builtin_amdgcn_readfirstlane(tid >> 6), lane = tid & 63, wr = wid >> 2, wc = wid & 3, fr = lane & 15, fq = lane >> 4;
    const int K = g.K, nt = K / BK;
    unsigned voffA[2], voffB[2];
#pragma unroll
    for (int i = 0; i < 2; ++i) { int R, C; stage_rc(tid * 16 + i * 8192, R, C); const int Rb = Epi::PERM ? ((R & ~31) + perm32(R & 31)) : R;
        voffA[i] = (unsigned)(R * K + C) * 2u; voffB[i] = (unsigned)(Rb * K + C) * 2u; }
    const size_t kstep = (size_t)(BK * 2);
    const size_t hstep = (size_t)HALF * K * 2;
    const size_t tstep = 2 * hstep;
    const unsigned ldsw = (unsigned)wid * 1024u;
    const int aoff = lds_byte(wr * 64 + fr, fq * 8), boff = lds_byte(wc * 32 + fr, fq * 8);
#define PG8_SA(b, h) (((b) * 2 + (h)) * HTB)
#define PG8_SB(b, h) ((4 + (b) * 2 + (h)) * HTB)
#define PG8_STAGE(bufoff, gbase, voff) do { _Pragma("unroll") for (int _i = 0; _i < 2; ++_i) \
        __builtin_amdgcn_global_load_lds((const unsigned*)((const char*)(gbase) + (voff)[_i]), (PG8_LAS unsigned*)(lds + (bufoff) + ldsw + _i * 8192), 16, 0, 0); } while (0)
#define PG8_LDA(dst, b, h) do { _Pragma("unroll") for (int m = 0; m < 4; ++m) _Pragma("unroll") for (int k = 0; k < 2; ++k) dst[m][k] = *(const PG8_LAS bf16x8*)(lds + PG8_SA(b, h) + aoff + m * 2048 + k * 1024); } while (0)
#define PG8_LDB(dst, b, h) do { _Pragma("unroll") for (int n = 0; n < 2; ++n) _Pragma("unroll") for (int k = 0; k < 2; ++k) dst[n][k] = *(const PG8_LAS bf16x8*)(lds + PG8_SB(b, h) + boff + n * 2048 + k * 1024); } while (0)
#define PG8_MMA(ai, bj, At, Bt) do { __builtin_amdgcn_s_setprio(1); _Pragma("unroll") for (int m = 0; m < 4; ++m) _Pragma("unroll") for (int n = 0; n < 2; ++n) _Pragma("unroll") for (int k = 0; k < 2; ++k) \
        acc[ai][bj][m][n] = __builtin_amdgcn_mfma_f32_16x16x32_bf16(Bt[n][k], At[m][k], acc[ai][bj][m][n], 0, 0, 0); __builtin_amdgcn_s_setprio(0); } while (0)
#define PG8_WAIT_V(n) asm volatile("s_waitcnt vmcnt(" #n ")" ::: "memory")
#define PG8_WAIT_L(n) asm volatile("s_waitcnt lgkmcnt(" #n ")" ::: "memory")
#define PG8_BAR __builtin_amdgcn_s_barrier()
#define PG8_SCHED __builtin_amdgcn_sched_barrier(0)
    Unit cur, nxt; int ui = 0;
    if (!S.next(0, cur)) return;
    f32x4 acc[2][2][4][2];
#pragma unroll
    for (int a = 0; a < 2; ++a)
#pragma unroll
        for (int b = 0; b < 2; ++b)
#pragma unroll
            for (int m = 0; m < 4; ++m)
#pragma unroll
                for (int n = 0; n < 2; ++n) acc[a][b][m][n] = (f32x4){0.f, 0.f, 0.f, 0.f};
    bf16x8 At[4][2], B0[2][2], B1[2][2];
    const char* cA = (const char*)g.A + (size_t)cur.pm * tstep + (size_t)cur.pn * g.a_gs; const char* cB = (const char*)g.Bt + (size_t)cur.pn * tstep;
    S.a_ready(cur);
    if constexpr (SP2) {
        PG8_STAGE(PG8_SB(0, 0), cB, voffB); PG8_STAGE(PG8_SB(0, 1), cB + hstep, voffB); PG8_STAGE(PG8_SA(0, 0), cA, voffA); PG8_STAGE(PG8_SA(0, 1), cA + hstep, voffA);
        if (wr == 1) PG8_BAR;
        PG8_WAIT_V(2); PG8_BAR;
        PG8_STAGE(PG8_SB(1, 0), cB + kstep, voffB); PG8_STAGE(PG8_SA(1, 0), cA + kstep, voffA); PG8_STAGE(PG8_SB(1, 1), cB + hstep + kstep, voffB);
        PG8_WAIT_V(6); PG8_BAR;
    } else {
        PG8_STAGE(PG8_SB(0, 0), cB, voffB); PG8_STAGE(PG8_SA(0, 0), cA, voffA); PG8_STAGE(PG8_SB(0, 1), cB + hstep, voffB); PG8_STAGE(PG8_SA(0, 1), cA + hstep, voffA);
        if (wr == 1) PG8_BAR;
        PG8_WAIT_V(4); PG8_BAR;
        PG8_STAGE(PG8_SB(1, 0), cB + kstep, voffB); PG8_STAGE(PG8_SA(1, 0), cA + kstep, voffA); PG8_STAGE(PG8_SB(1, 1), cB + hstep + kstep, voffB);
        PG8_WAIT_V(6); PG8_BAR;
    }
    for (;;) {
        const bool has_next = S.next(ui + 1, nxt);
        const char* nA = has_next ? (const char*)g.A + (size_t)nxt.pm * tstep + (size_t)nxt.pn * g.a_gs : cA; const char* nB = has_next ? (const char*)g.Bt + (size_t)nxt.pn * tstep : cB;
        for (int t = 0; t < nt; t += 2) {
            const bool last = (t == nt - 2);
            const char* a1 = cA + (size_t)(t + 1) * kstep;
            const char* a2 = last ? nA : cA + (size_t)(t + 2) * kstep; const char* b2 = last ? nB : cB + (size_t)(t + 2) * kstep;
            const char* a3 = a2 + kstep; const char* b3 = b2 + kstep;
            if (last && has_next) S.a_ready(nxt);
            if constexpr (SP2) {
            PG8_LDB(B0, 0, 0); PG8_LDB(B1, 0, 1); PG8_SCHED; PG8_LDA(At, 0, 0); PG8_STAGE(PG8_SA(1, 1), a1 + hstep, voffA);
            PG8_WAIT_V(8); PG8_WAIT_L(0); PG8_BAR; PG8_MMA(0, 0, At, B0); PG8_MMA(0, 1, At, B1); PG8_BAR; PG8_SCHED;
            PG8_LDA(At, 0, 1); PG8_STAGE(PG8_SB(0, 0), b2, voffB); PG8_STAGE(PG8_SB(0, 1), b2 + hstep, voffB); PG8_STAGE(PG8_SA(0, 0), a2, voffA);
            PG8_WAIT_V(8); PG8_WAIT_L(0); PG8_BAR; PG8_MMA(1, 0, At, B0); PG8_MMA(1, 1, At, B1); PG8_BAR; PG8_SCHED;
            PG8_LDB(B0, 1, 0); PG8_LDB(B1, 1, 1); PG8_SCHED; PG8_LDA(At, 1, 0); PG8_STAGE(PG8_SA(0, 1), a2 + hstep, voffA);
            PG8_WAIT_V(8); PG8_WAIT_L(0); PG8_BAR; PG8_MMA(0, 0, At, B0); PG8_MMA(0, 1, At, B1); PG8_BAR; PG8_SCHED;
            PG8_LDA(At, 1, 1); PG8_STAGE(PG8_SB(1, 0), b3, voffB); PG8_STAGE(PG8_SB(1, 1), b3 + hstep, voffB); PG8_STAGE(PG8_SA(1, 0), a3, voffA);
            PG8_WAIT_V(8); PG8_WAIT_L(0); PG8_BAR; PG8_MMA(1, 0, At, B0); PG8_MMA(1, 1, At, B1); PG8_BAR; PG8_SCHED;
            } else {
            PG8_LDB(B0, 0, 0); PG8_SCHED; PG8_LDA(At, 0, 0); PG8_STAGE(PG8_SA(1, 1), a1 + hstep, voffA);
            PG8_WAIT_L(8); PG8_BAR; PG8_WAIT_L(0); PG8_MMA(0, 0, At, B0); PG8_BAR; PG8_SCHED;
            PG8_LDB(B1, 0, 1); PG8_STAGE(PG8_SB(0, 0), b2, voffB);
            PG8_BAR; PG8_WAIT_L(0); PG8_MMA(0, 1, At, B1); PG8_BAR;
            PG8_LDA(At, 0, 1); PG8_STAGE(PG8_SA(0, 0), a2, voffA);
            PG8_BAR; PG8_WAIT_L(0); PG8_MMA(1, 0, At, B0); PG8_BAR; PG8_SCHED;
            PG8_STAGE(PG8_SB(0, 1), b2 + hstep, voffB);
            PG8_WAIT_V(6); PG8_BAR; PG8_MMA(1, 1, At, B1); PG8_BAR;
            PG8_LDB(B0, 1, 0); PG8_SCHED; PG8_LDA(At, 1, 0); PG8_STAGE(PG8_SA(0, 1), a2 + hstep, voffA);
            PG8_WAIT_L(8); PG8_BAR; PG8_WAIT_L(0); PG8_MMA(0, 0, At, B0); PG8_BAR; PG8_SCHED;
            PG8_LDB(B1, 1, 1); PG8_STAGE(PG8_SB(1, 0), b3, voffB);
            PG8_BAR; PG8_WAIT_L(0); PG8_MMA(0, 1, At, B1); PG8_BAR;
            PG8_LDA(At, 1, 1); PG8_STAGE(PG8_SA(1, 0), a3, voffA);
            PG8_BAR; PG8_WAIT_L(0); PG8_MMA(1, 0, At, B0); PG8_BAR; PG8_SCHED;
            PG8_STAGE(PG8_SB(1, 1), b3 + hstep, voffB);
            PG8_WAIT_V(6); PG8_BAR; PG8_MMA(1, 1, At, B1); PG8_BAR;
            }
        }
        if constexpr (ALIGN_EPI) { if (wr == 0) PG8_BAR; }
        if constexpr (!Epi::AFTER_DRAIN) { E(acc, cur, wr, wc, fr, fq, ui, lds); S.done(cur); }
        if (!has_next) break;
#pragma unroll
        for (int a = 0; a < 2; ++a)
#pragma unroll
            for (int b = 0; b < 2; ++b)
#pragma unroll
                for (int m = 0; m < 4; ++m)
#pragma unroll
                    for (int n = 0; n < 2; ++n) acc[a][b][m][n] = (f32x4){0.f, 0.f, 0.f, 0.f};
        cur = nxt; cA = nA; cB = nB; ++ui;
        if constexpr (ALIGN_EPI) { if (wr == 1) PG8_BAR; }
    }
    PG8_WAIT_V(0);
    if constexpr (!ALIGN_EPI) { if (wr == 0) PG8_BAR; }
    PG8_BAR;
    if constexpr (Epi::AFTER_DRAIN) { E.fused(acc, cur, wr, wc, fr, fq, lds, wid, lane); S.done(cur); }
#undef PG8_SA
#undef PG8_SB
#undef PG8_STAGE
#undef PG8_LDA
#undef PG8_LDB
#undef PG8_MMA
#undef PG8_WAIT_V
#undef PG8_WAIT_L
#undef PG8_BAR
#undef PG8_SCHED
}
}

#define LAS __attribute__((address_space(3)))
typedef unsigned short bf16_t;
typedef short bf16x8 __attribute__((ext_vector_type(8)));
typedef short s16x4 __attribute__((ext_vector_type(4)));
typedef float f32x4 __attribute__((ext_vector_type(4)));
typedef float f32x2 __attribute__((ext_vector_type(2)));
typedef unsigned u32x4 __attribute__((ext_vector_type(4)));
typedef unsigned u32x2 __attribute__((ext_vector_type(2)));

constexpr int NB = 16, SEQ = 2048, DM = 1024, MT = NB * SEQ, FF = 4096, NH = 8, HD = 128, DEPTH = 4;
constexpr float EPS = 1e-6f;
constexpr size_t MiB = 1u << 20;
constexpr int NB_C = 16;
constexpr int LDS_BYTES_C = 147456;
constexpr size_t WS_SSQ = 0;
constexpr size_t WS_KMEAN = 484 * MiB;
constexpr size_t KM_Q = (size_t)NB_C * 8 * 8 * 128;
constexpr size_t WS_BIAST = 2 * MiB + 768 * 1024;
constexpr size_t WS_LB = 3 * MiB;
constexpr size_t WS_BAR = 3 * MiB + 64 * 1024;
constexpr int LDS_BARST = LDS_BYTES_C - 64;
constexpr size_t WS_AWIN = 4 * MiB, WS_AWOUT = 20 * MiB, WS_BQKV = 24 * MiB, WS_BOUT = 30 * MiB, WS_CW = 32 * MiB, WS_W1 = 33 * MiB, WS_W2 = 65 * MiB;
constexpr size_t WS_XB = 98 * MiB, WS_O2 = 162 * MiB, WS_BIG = 226 * MiB, WS_SSQ1 = 482 * MiB, WS_END = 486 * MiB;
constexpr int LDS_BYTES = 147456;
constexpr int NTHREADS = 512;

__device__ __forceinline__ unsigned f2bf(float f) { unsigned u = __builtin_bit_cast(unsigned, f); return (u + 0x7fffu + ((u >> 16) & 1u)) >> 16; }
typedef __bf16 bf16x2_t __attribute__((ext_vector_type(2)));
__device__ __forceinline__ unsigned pk2(float lo, float hi) { f32x2 v = {lo, hi}; bf16x2_t b = __builtin_convertvector(v, bf16x2_t); return __builtin_bit_cast(unsigned, b); }
__device__ __forceinline__ float bf2f(unsigned h) { return __builtin_bit_cast(float, (h & 0xffffu) << 16); }
__device__ __forceinline__ float wave_sum(float v) {
#pragma unroll
    for (int o = 1; o < 64; o <<= 1) v += __shfl_xor(v, o);
    return v;
}
__device__ __forceinline__ u32x4 pair_tiles(u32x2 wa, u32x2 wb, int fq) {
    const bool odd = fq & 1;
    const unsigned sx = odd ? wa.x : wb.x, sy = odd ? wa.y : wb.y;
    const unsigned rx = (unsigned)__shfl_xor((int)sx, 16), ry = (unsigned)__shfl_xor((int)sy, 16);
    return odd ? (u32x4){rx, ry, wb.x, wb.y} : (u32x4){wa.x, wa.y, rx, ry};
}
#define MFMA16(a, b, c) __builtin_amdgcn_mfma_f32_16x16x32_bf16((a), (b), (c), 0, 0, 0)
#define LDS_WAIT() asm volatile("s_waitcnt lgkmcnt(0)" ::: "memory")
#define LDS_BARRIER() asm volatile("s_waitcnt lgkmcnt(0)\n\ts_barrier" ::: "memory")

__device__ __forceinline__ void p0_cvt_item(const float* W, int K, int N, bf16_t* WT, int row_off, const float* gain, int item, int lane) {
    const int nblk = N / 256, kb = item / nblk, nb = item % nblk, k0 = 16 * kb, n0 = 256 * nb + 4 * lane;
#pragma unroll
    for (int kk = 0; kk < 16; kk += 8) {
        f32x4 v[8];
#pragma unroll
        for (int j = 0; j < 8; ++j) { const float gk = gain ? gain[k0 + kk + j] : 1.f; v[j] = *(const f32x4*)(W + (size_t)(k0 + kk + j) * N + n0) * gk; }
#pragma unroll
        for (int c = 0; c < 4; ++c) { u32x4 o; o.x = pk2(v[0][c], v[1][c]); o.y = pk2(v[2][c], v[3][c]); o.z = pk2(v[4][c], v[5][c]); o.w = pk2(v[6][c], v[7][c]);
            *(u32x4*)(WT + (size_t)(row_off + n0 + c) * K + k0 + kk) = o; }
    }
}

struct Args {
    const float* in[15]; float* out; unsigned char* ws; int ph_lo, ph_hi;
};

__device__ __forceinline__ int t5_bucket(int n) {
    if (n < 16) return n;
    const float v = (__log2f((float)n * (1.0f / 16.0f)) * 16.0f) / 6.0f;
    int l = 16 + (int)v; return l < 31 ? l : 31;
}

__device__ __forceinline__ void p0_phase(const Args& a, LAS unsigned char* lds, int G, int wg, int part, bool split) {
    const int tid = opaque_tid(), lane = tid & 63, wave = tid >> 6;
    unsigned char* ws = a.ws;
    const float* norm_mix = a.in[1]; const float* norm_mlp = a.in[2];
    const int gw = wg * 8 + wave, NGW = G * 8;
    constexpr int I_AIN = (DM / 16) * (4096 / 256), I_SQ = (DM / 16) * (DM / 256), I_QKV = (DM / 16) * (3072 / 256), I_CW = (256 / 16) * (256 / 256), I_W1 = (DM / 16) * (FF / 256), I_W2 = (FF / 16) * (DM / 256);
    constexpr int NITEMS = 2 * I_AIN + 2 * I_SQ + I_QKV + I_SQ + 4 * I_CW + 4 * I_W1 + 4 * I_W2;
    constexpr int LATE0 = 2 * I_AIN + I_SQ + I_QKV + I_SQ + 4 * I_CW + 3 * I_W1 + 3 * I_W2;
    const int it_lo = !split ? 0 : (part == 0 ? 0 : (part == 1 ? I_AIN : LATE0)), it_hi = !split ? NITEMS : (part == 0 ? I_AIN : (part == 1 ? LATE0 : NITEMS));
    for (int it = it_lo + gw; it < it_hi; it += NGW) {
        int r = it;
        if (r < 2 * I_AIN) { const int j = r / I_AIN; r -= j * I_AIN;
            p0_cvt_item(a.in[4] + (size_t)j * DM * 4096, DM, 4096, (bf16_t*)(ws + WS_AWIN) + (size_t)j * 4096 * DM, 0, norm_mix + (3 * j) * DM, r, lane); continue; } r -= 2 * I_AIN;
        if (r < I_SQ) { p0_cvt_item(a.in[7], DM, DM, (bf16_t*)(ws + WS_AWOUT), 0, nullptr, r, lane); continue; } r -= I_SQ;
        if (r < I_QKV) { p0_cvt_item(a.in[8], DM, 3072, (bf16_t*)(ws + WS_BQKV), 0, norm_mix + 1 * DM, r, lane); continue; } r -= I_QKV;
        if (r < I_SQ) { p0_cvt_item(a.in[9], DM, DM, (bf16_t*)(ws + WS_BOUT), 0, nullptr, r, lane); continue; } r -= I_SQ;
        if (r < 4 * I_CW) { const int g = r / I_CW; r -= g * I_CW;
            p0_cvt_item(a.in[11] + (size_t)g * 256 * 256, 256, 256, (bf16_t*)(ws + WS_CW), g * 256, nullptr, r, lane); continue; } r -= 4 * I_CW;
        if (r < 3 * I_W1) { const int j = r / I_W1; r -= j * I_W1;
            p0_cvt_item(a.in[13] + (size_t)j * DM * FF, DM, FF, (bf16_t*)(ws + WS_W1) + (size_t)j * FF * DM, 0, norm_mlp + j * DM, r, lane); continue; } r -= 3 * I_W1;
        if (r < 3 * I_W2) { const int j = r / I_W2; r -= j * I_W2;
            p0_cvt_item(a.in[14] + (size_t)j * FF * DM, FF, DM, (bf16_t*)(ws + WS_W2) + (size_t)j * DM * FF, 0, nullptr, r, lane); continue; } r -= 3 * I_W2;
        if (r < I_SQ) { p0_cvt_item(a.in[7] + (size_t)DM * DM, DM, DM, (bf16_t*)(ws + WS_AWOUT) + (size_t)DM * DM, 0, nullptr, r, lane); continue; } r -= I_SQ;
        if (r < I_W1) { p0_cvt_item(a.in[13] + (size_t)3 * DM * FF, DM, FF, (bf16_t*)(ws + WS_W1) + (size_t)3 * FF * DM, 0, norm_mlp + 3 * DM, r, lane); continue; } r -= I_W1;
        p0_cvt_item(a.in[14] + (size_t)3 * FF * DM, FF, DM, (bf16_t*)(ws + WS_W2) + (size_t)3 * DM * FF, 0, nullptr, r, lane);
    }
    if (part != 0) return;
    const float* x = a.in[0]; float* ssq = (float*)(ws + WS_SSQ); bf16_t* xb = (bf16_t*)(ws + WS_XB);
    for (int m = gw; m < MT; m += NGW) {
        const f32x4* xr = (const f32x4*)(x + (size_t)m * DM) + lane; float s = 0.f;
        unsigned long long* o8 = (unsigned long long*)(xb + (size_t)m * DM) + lane;
#pragma unroll
        for (int j = 0; j < 4; ++j) { const f32x4 v = xr[64 * j]; s += (v.x * v.x + v.y * v.y) + (v.z * v.z + v.w * v.w);
            o8[64 * j] = (unsigned long long)pk2(v.x, v.y) | ((unsigned long long)pk2(v.z, v.w) << 32); }
        s = wave_sum(s);
        if (lane < 16) ssq[(size_t)m * 16 + lane] = (lane == 0) ? s : 0.f;
    }
    const int gt = wg * NTHREADS + tid, NGT = G * NTHREADS;
    float* biasT = (float*)(ws + WS_BIAST); const float* rel = a.in[10];
    for (int i = gt; i < NH * 2048; i += NGT) { const int h = i >> 11, dist = i & 2047; biasT[i] = rel[t5_bucket(dist) * NH + h] * 1.4426950408889634f; }
    float* kmz = (float*)(ws + WS_KMEAN);
    for (int i = gt; i < NB * 8 * 8 * 128; i += NGT) kmz[i] = 0.f;
    float* lb = (float*)(ws + WS_LB); const float* alb = a.in[5];
    for (int i = gt; i < 1024; i += NGT) { lb[i] = 0.f; lb[1024 + i] = 1.f / (1.f + __expf(alb[i] - alb[1024 + i])); }
}

__device__ __forceinline__ void kmean_phase(LAS unsigned char* lds, const bf16_t* QKV, float* kmean, int G, int wg) {
    const int tid = opaque_tid(), cp = tid & 127, rg = tid >> 7;
    LAS float* part = (LAS float*)lds;
    for (int u = wg; u < NB * 8 * 4; u += G) {
        const int cq = u & 3, n = (u >> 2) & 7, b = u >> 5;
        const bf16_t* kp = QKV + ((size_t)b * SEQ + n * 256 + rg * 64) * 3072 + 1024 + cq * 256 + 2 * cp;
        float s0 = 0.f, s1 = 0.f;
#pragma unroll 16
        for (int r = 0; r < 64; ++r) { const unsigned w = *(const unsigned*)(kp + (size_t)r * 3072); s0 += bf2f(w); s1 += bf2f(w >> 16); }
        __syncthreads();
        *(LAS f32x2*)(part + rg * 256 + 2 * cp) = (f32x2){s0, s1};
        __syncthreads();
        if (rg == 0) {
            const f32x2 a0 = *(const LAS f32x2*)(part + 2 * cp), a1 = *(const LAS f32x2*)(part + 256 + 2 * cp), a2 = *(const LAS f32x2*)(part + 512 + 2 * cp), a3 = *(const LAS f32x2*)(part + 768 + 2 * cp);
            const f32x2 m = ((a0 + a1) + (a2 + a3)) * (1.f / 256.f);
            const int c = cq * 256 + 2 * cp, h = c >> 7, d = c & 127;
            *(f32x2*)(kmean + ((size_t)((b * 8 + h) * 8 + n)) * 128 + d) = m;
        }
    }
}

__device__ __forceinline__ void attn_phase(LAS unsigned char* lds, const bf16_t* QKV, const float* kmean, const float* biasT, bf16_t* O, int G, int wg) {
    const int tid = opaque_tid(), lane = tid & 63, wid = tid >> 6, fr = lane & 15, fq = lane >> 4;
    constexpr int KS_OFF = 0, VT_OFF = 64 * 256, VT_STR = 136, STAGE = VT_OFF + 128 * 144, BT_OFF = 3 * STAGE;
    const int LK0 = fr * 256 + ((fq ^ (fr & 3)) << 4) + ((fr >> 2) << 6);
    LAS float* BT = (LAS float*)(lds + BT_OFF);
    for (int u = wg; u < 1024; u += G) {
        const int k4 = u >> 8, w8 = u & 255, half = w8 >> 7, bh = w8 & 127, b = bh >> 3, h = bh & 7;
        const int ob = half ? ((k4 == 0) ? 6 : (k4 == 1) ? 1 : (k4 == 2) ? 4 : 3) : ((k4 == 0) ? 7 : (k4 == 1) ? 0 : (k4 == 2) ? 5 : 2);
        const size_t rowbase = (size_t)b * SEQ;
        __syncthreads();
        u32x4 ka0, ka1, va0, va1;
#define ATT_LOAD(TI) do { const int t2_ = (TI); const bool own2_ = t2_ < 4; const int r2_ = t2_ - 4; const int blk2_ = own2_ ? ob : (r2_ >> 2), kt2_ = own2_ ? t2_ : (r2_ & 3); \
            const int key2_ = blk2_ * 256 + kt2_ * 64; \
            const bf16_t* kp_ = QKV + (rowbase + key2_ + (tid >> 3)) * 3072 + 1024 + h * 128 + (tid & 7) * 16; \
            const bf16_t* vp_ = QKV + (rowbase + key2_ + (tid & 63)) * 3072 + 2048 + h * 128 + (tid >> 6) * 16; \
            ka0 = *(const u32x4*)kp_; ka1 = *(const u32x4*)(kp_ + 8); va0 = *(const u32x4*)vp_; va1 = *(const u32x4*)(vp_ + 8); } while (0)
#define ATT_STAGE(BUF) do { LAS unsigned char* sb_ = lds + (BUF) * STAGE; \
            { LAS unsigned char* dst = sb_ + KS_OFF + (tid >> 3) * 256; const int kx_ = (tid >> 3) & 15, c0_ = (tid & 7) * 2; *(LAS u32x4*)(dst + ((c0_ ^ kx_) << 4)) = ka0; *(LAS u32x4*)(dst + (((c0_ + 1) ^ kx_) << 4)) = ka1; } \
            { LAS unsigned char* dst = sb_ + VT_OFF + ((tid >> 6) * 16) * VT_STR + (tid & 63) * 2; \
              _Pragma("unroll") for (int j = 0; j < 8; ++j) { *(LAS bf16_t*)(dst + j * VT_STR) = (bf16_t)(va0[j >> 1] >> (16 * (j & 1))); *(LAS bf16_t*)(dst + (8 + j) * VT_STR) = (bf16_t)(va1[j >> 1] >> (16 * (j & 1))); } } } while (0)
        ATT_LOAD(0);
        int tl = tid; asm volatile("" : "+v"(tl));
        for (int i = tl; i < 2048; i += NTHREADS) BT[i] = biasT[h * 2048 + i];
        LAS float* KM = (LAS float*)(lds + BT_OFF + 8192);
        if (ob > 3) { for (int i = tl; i < ob * 128; i += NTHREADS) KM[i] = kmean[(size_t)(bh * 8) * 128 + i]; }
        const int tq0 = ob * 256 + wid * 32 + fr;
        bf16x8 qf[2][4];
#pragma unroll
        for (int z = 0; z < 2; ++z) { const bf16_t* qp = QKV + (rowbase + tq0 + 16 * z) * 3072 + h * 128 + fq * 8;
#pragma unroll
            for (int ks = 0; ks < 4; ++ks) qf[z][ks] = *(const bf16x8*)(qp + ks * 32); }
        unsigned selmask[2] = {0u, 0u};
        if (ob <= 3) { selmask[0] = selmask[1] = (1u << ob) - 1u; }
        else {
            float v1[2] = {-INFINITY, -INFINITY}, v2[2] = {-INFINITY, -INFINITY}, v3[2] = {-INFINITY, -INFINITY}; int i1[2] = {0, 0}, i2[2] = {0, 0}, i3[2] = {0, 0};
            LDS_BARRIER();
#pragma unroll 2
            for (int n = 0; n < ob; ++n) {
                const LAS float* km = KM + n * 128 + fq * 8;
                float p0 = 0.f, p1 = 0.f;
#pragma unroll
                for (int ks = 0; ks < 4; ++ks) {
                    const f32x4 k0 = *(const LAS f32x4*)(km + ks * 32), k1 = *(const LAS f32x4*)(km + ks * 32 + 4);
#pragma unroll
                    for (int j = 0; j < 4; ++j) { p0 += bf2f((unsigned short)qf[0][ks][j]) * k0[j]; p0 += bf2f((unsigned short)qf[0][ks][4 + j]) * k1[j];
                                                  p1 += bf2f((unsigned short)qf[1][ks][j]) * k0[j]; p1 += bf2f((unsigned short)qf[1][ks][4 + j]) * k1[j]; }
                }
                p0 += __shfl_xor(p0, 16); p0 += __shfl_xor(p0, 32); p1 += __shfl_xor(p1, 16); p1 += __shfl_xor(p1, 32);
#pragma unroll
                for (int z = 0; z < 2; ++z) { const float p = z ? p1 : p0;
                    if (p > v1[z]) { v3[z] = v2[z]; i3[z] = i2[z]; v2[z] = v1[z]; i2[z] = i1[z]; v1[z] = p; i1[z] = n; }
                    else if (p > v2[z]) { v3[z] = v2[z]; i3[z] = i2[z]; v2[z] = p; i2[z] = n; }
                    else if (p > v3[z]) { v3[z] = p; i3[z] = n; } }
            }
            selmask[0] = (1u << i1[0]) | (1u << i2[0]) | (1u << i3[0]); selmask[1] = (1u << i1[1]) | (1u << i2[1]) | (1u << i3[1]);
        }
        const int nTiles = 4 + ob * 4;
        float m_run[2] = {-1e30f, -1e30f}, l_run[2] = {0.f, 0.f};
        f32x4 oacc[2][8];
#pragma unroll
        for (int z = 0; z < 2; ++z)
#pragma unroll
            for (int e = 0; e < 8; ++e) oacc[z][e] = (f32x4){0.f, 0.f, 0.f, 0.f};
        ATT_STAGE(0);
        ATT_LOAD(1);
        const bool skew = wid >= 4;
        bf16x8 pf[2][2]; bool pend = false; int pend_buf = 0, cur = 0;
#define ATT_PV(SB) do { const LAS unsigned char* sv_ = (SB); __builtin_amdgcn_s_setprio(1); \
            _Pragma("unroll") for (int e = 0; e < 8; ++e) _Pragma("unroll") for (int i = 0; i < 2; ++i) { \
                const LAS unsigned char* vr = sv_ + VT_OFF + (e * 16 + fr) * VT_STR + (32 * i + fq * 4) * 2; \
                const s16x4 lo = *(const LAS s16x4*)vr, hi = *(const LAS s16x4*)(vr + 32); \
                const bf16x8 af = __builtin_shufflevector(lo, hi, 0, 1, 2, 3, 4, 5, 6, 7); \
                oacc[0][e] = MFMA16(af, pf[0][i], oacc[0][e]); oacc[1][e] = MFMA16(af, pf[1][i], oacc[1][e]); \
                if (i == 1 && (e & 1)) __builtin_amdgcn_sched_barrier(0); } __builtin_amdgcn_s_setprio(0); } while (0)
        for (int ti = 0; ti < nTiles; ++ti) {
            const bool own = ti < 4; const int r_ = ti - 4; const int blk = own ? ob : (r_ >> 2), kt = own ? ti : (r_ & 3);
            const int key0 = blk * 256 + kt * 64;
            LDS_BARRIER();
            const int nxt = (cur == 2) ? 0 : cur + 1;
            if (ti + 1 < nTiles) { ATT_STAGE(nxt); if (ti + 2 < nTiles) ATT_LOAD(ti + 2); }
            const LAS unsigned char* sb = lds + cur * STAGE;
            if (pend) { ATT_PV(lds + pend_buf * STAGE); pend = false; }
            const int cur_ = cur; cur = nxt;
            if (own && kt * 64 > wid * 32 + 31) continue;
            f32x4 sc[2][4];
            __builtin_amdgcn_s_setprio(1);
#pragma unroll
            for (int st = 0; st < 4; ++st) { sc[0][st] = (f32x4){0.f, 0.f, 0.f, 0.f}; sc[1][st] = (f32x4){0.f, 0.f, 0.f, 0.f};
#pragma unroll
                for (int ks = 0; ks < 4; ++ks) { const bf16x8 af = *(const LAS bf16x8*)(sb + KS_OFF + st * 4096 + (LK0 ^ (ks << 6)));
                    sc[0][st] = MFMA16(af, qf[0][ks], sc[0][st]); sc[1][st] = MFMA16(af, qf[1][ks], sc[1][st]); }
                __builtin_amdgcn_sched_barrier(0); }
            __builtin_amdgcn_s_setprio(0);
#pragma unroll
            for (int z = 0; z < 2; ++z) {
                const int tq = tq0 + 16 * z;
                const bool selok = (selmask[z] >> blk) & 1u;
                float mx = -1e30f;
                if (own) {
#pragma unroll
                    for (int st = 0; st < 4; ++st)
#pragma unroll
                        for (int j = 0; j < 4; ++j) { const int dist = tq - (key0 + st * 16 + fq * 4 + j);
                            float s = sc[z][st][j] + BT[dist < 0 ? 0 : dist]; s = (dist >= 0) ? s : -1e30f; sc[z][st][j] = s; mx = fmaxf(mx, s); }
                } else {
                    const LAS float* bp = BT + (tq0 - key0 - fq * 4 - 63);
#pragma unroll
                    for (int st = 0; st < 4; ++st)
#pragma unroll
                        for (int j = 0; j < 4; ++j) { const float s = sc[z][st][j] + bp[63 - st * 16 - j + 16 * z]; sc[z][st][j] = s; mx = fmaxf(mx, s); }
                    mx = selok ? mx : -1e30f;
                }
                mx = fmaxf(mx, __shfl_xor(mx, 16)); mx = fmaxf(mx, __shfl_xor(mx, 32));
                const float m_new = fmaxf(m_run[z], mx), alpha = __builtin_amdgcn_exp2f(m_run[z] - m_new); m_run[z] = m_new;
                const float m_sub = (own || selok) ? m_new : 1e30f;
                float ps = 0.f;
#pragma unroll
                for (int st = 0; st < 4; ++st)
#pragma unroll
                    for (int j = 0; j < 4; ++j) { const float p = __builtin_amdgcn_exp2f(sc[z][st][j] - m_sub); sc[z][st][j] = p; ps += p; }
                l_run[z] = l_run[z] * alpha + ps;
                if (__builtin_amdgcn_ballot_w64(alpha != 1.0f) != 0ull) {
#pragma unroll
                    for (int e = 0; e < 8; ++e) oacc[z][e] = oacc[z][e] * alpha;
                }
#pragma unroll
                for (int i = 0; i < 2; ++i) { u32x4 w; w.x = pk2(sc[z][2 * i][0], sc[z][2 * i][1]); w.y = pk2(sc[z][2 * i][2], sc[z][2 * i][3]); w.z = pk2(sc[z][2 * i + 1][0], sc[z][2 * i + 1][1]); w.w = pk2(sc[z][2 * i + 1][2], sc[z][2 * i + 1][3]); pf[z][i] = __builtin_bit_cast(bf16x8, w); }
            }
            if (skew) { pend = true; pend_buf = cur_; } else ATT_PV(sb);
        }
        if (pend) ATT_PV(lds + pend_buf * STAGE);
#undef ATT_PV
#pragma unroll
        for (int z = 0; z < 2; ++z) {
            float l = l_run[z]; l += __shfl_xor(l, 16); l += __shfl_xor(l, 32);
            const float inv = 1.f / l;
            bf16_t* op = O + (rowbase + tq0 + 16 * z) * 1024 + h * 128 + ((fq & 1) ? 16 + (fq - 1) * 4 : fq * 4);
#pragma unroll
            for (int e = 0; e < 8; e += 2) { u32x2 wa, wb; wa.x = pk2(oacc[z][e][0] * inv, oacc[z][e][1] * inv); wa.y = pk2(oacc[z][e][2] * inv, oacc[z][e][3] * inv);
                wb.x = pk2(oacc[z][e + 1][0] * inv, oacc[z][e + 1][1] * inv); wb.y = pk2(oacc[z][e + 1][2] * inv, oacc[z][e + 1][3] * inv);
                *(u32x4*)(op + e * 16) = pair_tiles(wa, wb, fq); }
        }
    }
}

#undef ATT_LOAD
#undef ATT_STAGE
__device__ __forceinline__ void gla_phase(LAS unsigned char* lds, const bf16_t* P, const float* hn, bf16_t* O, int G, int wg) {
    const int tid = opaque_tid(), lane = tid & 63, wid = tid >> 6, fr = lane & 15, fq = lane >> 4;
    constexpr int QT = 0, KT = 16384, ST = 32768, KTT = 65536, VT = 81920, AM = 98304, PART = 106496, SSQX = 110592, HNL = 111104;
    const int LK0 = fr * 256 + ((fq ^ (fr & 3)) << 4) + ((fr >> 2) << 6);
    const int LS0 = fr * 128 + ((fq ^ ((fr >> 1) & 3)) << 4) + ((fr >> 3) << 6);
    constexpr float LOG2E = 1.4426950408889634f;
    const int dp = tid & 63, tq = tid >> 6;
    const int tt = wid & 3, eh = wid >> 2;
#define FRAGK(base, X, ks) (*(const LAS bf16x8*)(lds + (base) + (X) * 4096 + (LK0 ^ ((ks) << 6))))
#define FRAGS(base, X, ks) (*(const LAS bf16x8*)(lds + (base) + (X) * 2048 + (LS0 ^ ((ks) << 6))))
#define GLA_EPILOGUE(CC) do { const int t_ = tt * 16 + fr; const float tot_ = ((LAS float*)(lds + SSQX))[t_] + ((LAS float*)(lds + SSQX))[64 + t_]; \
        const float rstd_ = __builtin_amdgcn_rsqf(tot_ * (1.f / 128.f) + EPS); const size_t row_ = (size_t)b * SEQ + (CC) * 64 + t_; \
        u32x2 wq_[4]; \
        _Pragma("unroll") for (int i = 0; i < 4; ++i) { const int e0 = (eh * 4 + i) * 16 + fq * 4; const u32x2 g = gpre[i]; const f32x4 hv = *(const LAS f32x4*)(lds + HNL + e0 * 4); \
            wq_[i].x = pk2(oacc[i][0] * rstd_ * hv[0] * bf2f(g.x), oacc[i][1] * rstd_ * hv[1] * bf2f(g.x >> 16)); wq_[i].y = pk2(oacc[i][2] * rstd_ * hv[2] * bf2f(g.y), oacc[i][3] * rstd_ * hv[3] * bf2f(g.y >> 16)); } \
        _Pragma("unroll") for (int i = 0; i < 4; i += 2) *(u32x4*)(O + row_ * 1024 + h * 128 + (eh * 4 + i) * 16 + ((fq & 1) ? 16 + (fq - 1) * 4 : fq * 4)) = pair_tiles(wq_[i], wq_[i + 1], fq); } while (0)
#define GLA_GLOAD(CC) do { const size_t row_ = (size_t)b * SEQ + (CC) * 64 + tt * 16 + fr; \
        _Pragma("unroll") for (int i = 0; i < 4; ++i) gpre[i] = *(const u32x2*)(P + row_ * 4096 + 3072 + h * 128 + (eh * 4 + i) * 16 + fq * 4); } while (0)
    for (int unit = wg; unit < NB * NH; unit += G) {
        const int b = unit >> 3, h = unit & 7;
        __syncthreads();
        if (tid < 128) ((LAS float*)(lds + HNL))[tid] = hn[tid];
        f32x4 sacc[8];
#pragma unroll
        for (int e = 0; e < 8; ++e) sacc[e] = (f32x4){0.f, 0.f, 0.f, 0.f};
        const bf16_t* pbase = P + ((size_t)b * SEQ) * 4096 + h * 128 + 2 * dp;
        unsigned rq[8], rl[8], rv[8];
        { const bf16_t* pp = pbase + (size_t)(tq * 8) * 4096;
#pragma unroll
          for (int i = 0; i < 8; ++i) { rq[i] = *(const unsigned*)(pp + (size_t)i * 4096); rl[i] = *(const unsigned*)(pp + (size_t)i * 4096 + 1024); rv[i] = *(const unsigned*)(pp + (size_t)i * 4096 + 2048); } }
        f32x4 oacc[4]; u32x2 gpre[4];
#pragma unroll
        for (int i = 0; i < 4; ++i) { oacc[i] = (f32x4){0.f, 0.f, 0.f, 0.f}; gpre[i] = (u32x2){0u, 0u}; }
        for (int c = 0; c < 32; ++c) {
            float q0[8], q1[8], l0[8], l1[8], b0[8], b1[8]; unsigned vt0[4], vt1[4];
            float run0 = 0.f, run1 = 0.f;
#pragma unroll
            for (int i = 0; i < 8; ++i) { q0[i] = bf2f(rq[i]); q1[i] = bf2f(rq[i] >> 16); l0[i] = bf2f(rl[i]) * LOG2E; l1[i] = bf2f(rl[i] >> 16) * LOG2E; run0 += l0[i]; b0[i] = run0; run1 += l1[i]; b1[i] = run1; }
#pragma unroll
            for (int i = 0; i < 4; ++i) { vt0[i] = (rv[2 * i] & 0xffffu) | (rv[2 * i + 1] << 16); vt1[i] = (rv[2 * i] >> 16) | (rv[2 * i + 1] & 0xffff0000u); }
            { const int cn = (c < 31) ? c + 1 : 31;
              const bf16_t* pp = pbase + (size_t)(cn * 64 + tq * 8) * 4096;
#pragma unroll
                for (int i = 0; i < 8; ++i) { rq[i] = *(const unsigned*)(pp + (size_t)i * 4096); rl[i] = *(const unsigned*)(pp + (size_t)i * 4096 + 1024); rv[i] = *(const unsigned*)(pp + (size_t)i * 4096 + 2048); } }
            *(LAS f32x2*)(lds + PART + (tq * 128 + 2 * dp) * 4) = (f32x2){run0, run1};
            LDS_BARRIER();
            if (c > 0) GLA_EPILOGUE(c - 1);
            GLA_GLOAD(c);
            float off0 = 0.f, off1 = 0.f, bm0 = 0.f, bm1 = 0.f;
#pragma unroll
            for (int s2 = 0; s2 < 4; ++s2) { const f32x2 p = *(const LAS f32x2*)(lds + PART + (s2 * 128 + 2 * dp) * 4); if (s2 < tq) { off0 += p.x; off1 += p.y; } bm0 += p.x; bm1 += p.y; }
#pragma unroll
            for (int s2 = 4; s2 < 7; ++s2) { const f32x2 p = *(const LAS f32x2*)(lds + PART + (s2 * 128 + 2 * dp) * 4); if (s2 < tq) { off0 += p.x; off1 += p.y; } }
            f32x4 cm4;
            { f32x4 bm4 = (f32x4){0.f, 0.f, 0.f, 0.f};
#pragma unroll
              for (int s2 = 0; s2 < 4; ++s2) bm4 += *(const LAS f32x4*)(lds + PART + (s2 * 128 + wid * 16 + fq * 4) * 4);
#pragma unroll
              for (int j = 0; j < 4; ++j) cm4[j] = __builtin_amdgcn_exp2f(bm4[j]); }
#pragma unroll
            for (int e = 0; e < 8; ++e) { const int et = ((e < 4) ? eh : (eh ^ 1)) * 4 + (e & 3);
                u32x2 w; w.x = pk2(sacc[e][0] * cm4[0], sacc[e][1] * cm4[1]); w.y = pk2(sacc[e][2] * cm4[2], sacc[e][3] * cm4[3]);
                *(LAS u32x2*)(lds + ST + (et * 16 + fr) * 256 + (((wid * 2 + (fq >> 1)) ^ fr) << 4) + (fq & 1) * 8) = w; }
            unsigned kt0[4], kt1[4];
#pragma unroll
            for (int i = 0; i < 8; i += 2) {
                float k0v[2], k1v[2];
#pragma unroll
                for (int z = 0; z < 2; ++z) {
                    const int ii = i + z, t = tq * 8 + ii; const float x0 = b0[ii] + off0 - bm0, x1 = b1[ii] + off1 - bm1;
                    const float kv0 = 1.f - __builtin_amdgcn_exp2f(l0[ii]), kv1 = 1.f - __builtin_amdgcn_exp2f(l1[ii]);
                    const float e10 = __builtin_amdgcn_exp2f(fminf(x0, 80.f)), e20 = __builtin_amdgcn_exp2f(fminf(-x0, 80.f));
                    const float e11 = __builtin_amdgcn_exp2f(fminf(x1, 80.f)), e21 = __builtin_amdgcn_exp2f(fminf(-x1, 80.f));
                    k0v[z] = kv0 * e20; k1v[z] = kv1 * e21;
                    const int wo = t * 256 + ((((dp >> 2) ^ (t & 15))) << 4) + (dp & 3) * 4;
                    *(LAS unsigned*)(lds + QT + wo) = pk2(q0[ii] * e10, q1[ii] * e11);
                    *(LAS unsigned*)(lds + KT + wo) = pk2(k0v[z], k1v[z]);
                }
                kt0[i >> 1] = pk2(k0v[0], k0v[1]); kt1[i >> 1] = pk2(k1v[0], k1v[1]);
            }
            { const int so = (2 * dp) * 128 + ((tq ^ (dp & 7)) << 4); constexpr int TS = 128;
              LAS unsigned char* dk = lds + KTT + so; LAS unsigned char* dv = lds + VT + so;
              *(LAS u32x4*)dk = (u32x4){kt0[0], kt0[1], kt0[2], kt0[3]}; *(LAS u32x4*)(dk + TS) = (u32x4){kt1[0], kt1[1], kt1[2], kt1[3]};
              *(LAS u32x4*)dv = (u32x4){vt0[0], vt0[1], vt0[2], vt0[3]}; *(LAS u32x4*)(dv + TS) = (u32x4){vt1[0], vt1[1], vt1[2], vt1[3]}; }
            LDS_BARRIER();
            { const int st = wid & 3, tA = (wid >> 2) * 2;
              bf16x8 kA[4], qA[2][4], qB[4], sB[4][4];
#pragma unroll
              for (int ks = 0; ks < 4; ++ks) { kA[ks] = FRAGK(KT, st, ks); qA[0][ks] = FRAGK(QT, tA, ks); qA[1][ks] = FRAGK(QT, tA + 1, ks); }
#pragma unroll
              for (int ks = 0; ks < 4; ++ks) qB[ks] = FRAGK(QT, tt, ks);
              __builtin_amdgcn_sched_barrier(0);
              f32x4 accA[2];
#pragma unroll
              for (int z = 0; z < 2; ++z) { accA[z] = (f32x4){0.f, 0.f, 0.f, 0.f};
                if (tA + z >= st) {
#pragma unroll
                    for (int ks = 0; ks < 4; ++ks) accA[z] = MFMA16(kA[ks], qA[z][ks], accA[z]);
                } }
              __builtin_amdgcn_sched_barrier(0);
#pragma unroll
              for (int i = 0; i < 4; ++i)
#pragma unroll
                for (int ks = 0; ks < 4; ++ks) sB[i][ks] = FRAGK(ST, eh * 4 + i, ks);
              __builtin_amdgcn_sched_barrier(0);
#pragma unroll
              for (int z = 0; z < 2; ++z) { const int t = (tA + z) * 16 + fr, s0_ = st * 16 + fq * 4;
                u32x2 w; w.x = pk2(t >= s0_ ? accA[z][0] : 0.f, t >= s0_ + 1 ? accA[z][1] : 0.f); w.y = pk2(t >= s0_ + 2 ? accA[z][2] : 0.f, t >= s0_ + 3 ? accA[z][3] : 0.f);
                *(LAS u32x2*)(lds + AM + t * 128 + ((((st * 2 + (fq >> 1))) ^ ((fr >> 1) & 7)) << 4) + (fq & 1) * 8) = w; }
#pragma unroll
              for (int i = 0; i < 4; ++i) { oacc[i] = (f32x4){0.f, 0.f, 0.f, 0.f};
#pragma unroll
                for (int ks = 0; ks < 4; ++ks) oacc[i] = MFMA16(sB[i][ks], qB[ks], oacc[i]); }
            }
            LDS_BARRIER();
            { bf16x8 aM[2], vO[4][2], kD[2], vX[4][2];
#pragma unroll
              for (int ks = 0; ks < 2; ++ks) { aM[ks] = FRAGS(AM, tt, ks);
#pragma unroll
                for (int i = 0; i < 4; ++i) vO[i][ks] = FRAGS(VT, eh * 4 + i, ks); }
              __builtin_amdgcn_sched_barrier(0);
#pragma unroll
              for (int ks = 0; ks < 2; ++ks) { kD[ks] = FRAGS(KTT, wid, ks);
#pragma unroll
                for (int i = 0; i < 4; ++i) vX[i][ks] = FRAGS(VT, (eh ^ 1) * 4 + i, ks); }
#pragma unroll
              for (int i = 0; i < 4; ++i)
#pragma unroll
                for (int ks = 0; ks < 2; ++ks) oacc[i] = MFMA16(vO[i][ks], aM[ks], oacc[i]);
              __builtin_amdgcn_sched_barrier(0);
              f32x4 dec4, cl4;
              { f32x4 bm4 = (f32x4){0.f, 0.f, 0.f, 0.f}, bl4 = (f32x4){0.f, 0.f, 0.f, 0.f};
#pragma unroll
                for (int s2 = 0; s2 < 8; ++s2) { const f32x4 p = *(const LAS f32x4*)(lds + PART + (s2 * 128 + wid * 16 + fq * 4) * 4); if (s2 < 4) bm4 += p; bl4 += p; }
#pragma unroll
                for (int j = 0; j < 4; ++j) { dec4[j] = __builtin_amdgcn_exp2f(bl4[j]); cl4[j] = __builtin_amdgcn_exp2f(bl4[j] - bm4[j]); } }
#pragma unroll
              for (int e = 0; e < 8; ++e) { f32x4 tmp = (f32x4){0.f, 0.f, 0.f, 0.f};
#pragma unroll
                for (int ks = 0; ks < 2; ++ks) tmp = MFMA16(kD[ks], (e < 4) ? vO[e & 3][ks] : vX[e & 3][ks], tmp);
                sacc[e] = sacc[e] * dec4 + tmp * cl4; }
            }
            { float s = 0.f;
#pragma unroll
              for (int i = 0; i < 4; ++i) s += (oacc[i][0] * oacc[i][0] + oacc[i][1] * oacc[i][1]) + (oacc[i][2] * oacc[i][2] + oacc[i][3] * oacc[i][3]);
              s += __shfl_xor(s, 16); s += __shfl_xor(s, 32);
              if (fq == 0) ((LAS float*)(lds + SSQX))[eh * 64 + tt * 16 + fr] = s; }
        }
        __syncthreads();
        GLA_EPILOGUE(31);
    }
#undef FRAGK
#undef FRAGS
#undef GLA_EPILOGUE
#undef GLA_GLOAD
}

__device__ __forceinline__ f32x2 ldx2(const bf16_t* p) { const unsigned w = *(const unsigned*)p; return (f32x2){__builtin_bit_cast(float, w << 16), __builtin_bit_cast(float, w & 0xffff0000u)}; }
template <int W> __device__ __forceinline__ void pool_unit(const bf16_t* x, const LAS float* rs, f32x2 gn, bf16_t* Ag, size_t rb, int t0, int c, int g) {
    f32x2 ring[16], hn_[16];
#pragma unroll
    for (int i = 0; i < 16; ++i) { const int t = t0 - 16 + i; ring[i] = (t >= 0) ? ldx2(x + (rb + t) * 1024 + c) * rs[i] * gn : (f32x2){0.f, 0.f}; }
    f32x2 win = (f32x2){0.f, 0.f};
#pragma unroll
    for (int i = 16 - (W - 1); i < 16; ++i) win += ring[i];
#pragma unroll
    for (int bt = 0; bt < 4; ++bt) {
#pragma unroll
        for (int i = 0; i < 16; ++i) hn_[i] = ldx2(x + (rb + t0 + bt * 16 + i) * 1024 + c) * rs[16 + bt * 16 + i] * gn;
#pragma unroll
        for (int i = 0; i < 16; ++i) { const int t = t0 + bt * 16 + i;
            win += hn_[i]; const float inv = 1.f / (float)((t + 1) < W ? (t + 1) : W);
            const f32x2 a = win * inv - hn_[i];
            *(unsigned*)(Ag + ((size_t)g * MT + rb + t) * 256 + (c & 255)) = pk2(a.x, a.y);
            win -= (i - W + 1 >= 0) ? hn_[(i - W + 1 >= 0) ? (i - W + 1) : 0] : ring[(i - W + 17) & 15]; }
#pragma unroll
        for (int i = 0; i < 16; ++i) ring[i] = hn_[i];
    }
}
__device__ __forceinline__ void pool_phase(LAS unsigned char* lds, const bf16_t* x, const float* ssq, const float* gain, bf16_t* Ag, int G, int wg) {
    const int tid = opaque_tid(); const int c = 2 * tid, g = c >> 8;
    const f32x2 gn = *(const f32x2*)(gain + c);
    LAS float* rs = (LAS float*)lds;
    for (int u = wg; u < NB * 32; u += G) {
        const int b = u >> 5, t0 = (u & 31) * 64; const size_t rb = (size_t)b * SEQ;
        __syncthreads();
        if (tid < 80) { const int t = t0 - 16 + tid; rs[tid] = (t >= 0) ? __builtin_amdgcn_rsqf(pg8::ssq_row(ssq, (int)(rb + t)) * (1.f / 1024.f) + EPS) : 0.f; }
        __syncthreads();
        if (g == 0) pool_unit<2>(x, rs, gn, Ag, rb, t0, c, g); else if (g == 1) pool_unit<4>(x, rs, gn, Ag, rb, t0, c, g);
        else if (g == 2) pool_unit<8>(x, rs, gn, Ag, rb, t0, c, g); else pool_unit<16>(x, rs, gn, Ag, rb, t0, c, g);
    }
}

__device__ __forceinline__ void final_phase(const bf16_t* xb, float* out, const float* ssq, const float* gain, int G, int wg) {
    const int tid = opaque_tid(), lane = tid & 63, wave = tid >> 6; const int gw = wg * 8 + wave, NGW = G * 8;
    f32x4 gv[4];
#pragma unroll
    for (int j = 0; j < 4; ++j) gv[j] = ((const f32x4*)gain)[lane + 64 * j];
    for (int m = gw; m < MT; m += NGW) {
        const float rs = __builtin_amdgcn_rsqf(pg8::ssq_row(ssq, m) * (1.f / 1024.f) + EPS);
        const u32x2* xr = (const u32x2*)(xb + (size_t)m * DM) + lane; f32x4* orow = (f32x4*)(out + (size_t)m * DM) + lane;
#pragma unroll
        for (int j = 0; j < 4; ++j) { const u32x2 w = xr[64 * j];
            const f32x4 v = {__builtin_bit_cast(float, w.x << 16), __builtin_bit_cast(float, w.x & 0xffff0000u), __builtin_bit_cast(float, w.y << 16), __builtin_bit_cast(float, w.y & 0xffff0000u)};
            orow[64 * j] = v * rs * gv[j]; }
    }
}

#define XB_TMO      128
#define XB_XCNT(j)  (256  + 64 * (j))
#define XB_XSUB(j)  (1280 + 64 * (j))
#define XB_XGEN(j)  (2304 + 64 * (j))
#define XB_TOP      3328
#define XB_TOPGEN   3392
#define XCD_BAR_WORDS 3456
#define XB_SPIN_CAP (1u << 18)

__device__ __forceinline__ unsigned xb_ld(unsigned* p)              { return __hip_atomic_load(p, __ATOMIC_RELAXED, __HIP_MEMORY_SCOPE_AGENT); }
__device__ __forceinline__ unsigned xb_add(unsigned* p, unsigned v) { return __hip_atomic_fetch_add(p, v, __ATOMIC_RELAXED, __HIP_MEMORY_SCOPE_AGENT); }
__device__ __forceinline__ unsigned xb_xcc_id() { return (unsigned)__builtin_amdgcn_s_getreg((3 << 11) | 20) & 0xFu; }
#define XB_SPIN(cond, bar) do { unsigned _sp = 0; while (cond) { __builtin_amdgcn_s_sleep(1); \
    if ((++_sp & 255u) == 0u) { if (xb_ld(&(bar)[XB_TMO])) break; if (_sp > XB_SPIN_CAP) { atomicAdd(&(bar)[XB_TMO], 1u); break; } } } } while (0)

struct XcdBarrier {
    unsigned* bar; unsigned x;
    volatile LAS unsigned* st;
};

__device__ __forceinline__ XcdBarrier xcd_barrier_post(unsigned* bar, volatile LAS unsigned* st) {
    XcdBarrier b; b.bar = bar; b.x = xb_xcc_id(); b.st = st;
    if (threadIdx.x == 0) (void)xb_add(&bar[XB_XCNT(b.x)], 1u);
    return b;
}
__device__ __forceinline__ void xcd_barrier_complete(unsigned* bar, unsigned x, unsigned& nloc, unsigned& nx) {
    const unsigned G = gridDim.x * gridDim.y * gridDim.z;
    unsigned sum, cnt, mine, sp = 0u;
    for (;;) {
        sum = 0u; cnt = 0u; mine = 0u;
#pragma unroll
        for (unsigned j = 0; j < 16; ++j) { const unsigned c = xb_ld(&bar[XB_XCNT(j)]); sum += c; cnt += (c > 0u) ? 1u : 0u; mine = (j == x) ? c : mine; }
        if (sum == G) break;
        __builtin_amdgcn_s_sleep(1);
        if ((++sp & 255u) == 0u) { if (xb_ld(&bar[XB_TMO])) break; if (sp > XB_SPIN_CAP) { atomicAdd(&bar[XB_TMO], 1u); break; } }
    }
    nloc = mine > 0u ? mine : 1u; nx = cnt > 0u ? cnt : 1u;
}

__device__ __forceinline__ void xcd_barrier(const XcdBarrier& b) {
    asm volatile("s_waitcnt vmcnt(0)" ::: "memory");
    __syncthreads();
    if (threadIdx.x == 0) {
        unsigned* bar = b.bar;
        __builtin_amdgcn_s_waitcnt(0);
        unsigned nloc = b.st[0], nx = b.st[1];
        if (nloc == 0u) { xcd_barrier_complete(bar, b.x, nloc, nx); b.st[0] = nloc; b.st[1] = nx; }
        const unsigned old = xb_add(&bar[XB_XSUB(b.x)], 1u);
        const unsigned gen = old / nloc;
        if (old + 1u == (gen + 1u) * nloc) {
            __builtin_amdgcn_fence(__ATOMIC_RELEASE, "agent");
            asm volatile("s_waitcnt vmcnt(0)" ::: "memory");
            const unsigned og = xb_add(&bar[XB_TOP], 1u);
            const unsigned tg = og / nx;
            if (og + 1u == (tg + 1u) * nx) xb_add(&bar[XB_TOPGEN], 1u);
            else XB_SPIN(xb_ld(&bar[XB_TOPGEN]) == tg, bar);
            __builtin_amdgcn_fence(__ATOMIC_ACQUIRE, "agent");
            xb_add(&bar[XB_XGEN(b.x)], 1u);
            asm volatile("s_waitcnt vmcnt(0)" ::: "memory");
        } else {
            XB_SPIN(xb_ld(&bar[XB_XGEN(b.x)]) == gen, bar);
            __builtin_amdgcn_fence(__ATOMIC_ACQUIRE, "agent");
            asm volatile("s_waitcnt vmcnt(0)" ::: "memory");
        }
    }
    __syncthreads();
}

template <class Sched> __device__ __forceinline__ bool build_rstd_table(LAS unsigned char* lds, const Sched& S, const float* ssq) {
    const int tid = opaque_tid(), i = tid >> 6, r0 = tid & 63;
    pg8::Unit uu;
    if (S.next(8, uu)) return false;
    LAS float* tab = (LAS float*)(lds + pg8::RSTD_TAB);
    if (S.next(i, uu)) {
#pragma unroll
        for (int k = 0; k < 4; ++k) tab[i * 256 + r0 + 64 * k] = __builtin_amdgcn_rsqf(pg8::ssq_row(ssq, uu.pm * 256 + r0 + 64 * k) * (1.0f / 1024.0f) + EPS);
    }
    __syncthreads();
    return true;
}

constexpr int NPHASES = 21;
#ifndef REP_P0
#define REP_P0 1
#endif
#ifndef REP_GLA
#define REP_GLA 1
#endif
#ifndef REP_ATTN
#define REP_ATTN 1
#endif
#ifndef REP_POOL
#define REP_POOL 1
#endif
#ifndef REP_G3
#define REP_G3 1
#endif
#ifndef REP_G1
#define REP_G1 1
#endif
#ifndef REP_KMEAN
#define REP_KMEAN 1
#endif
#ifndef EXTRA_SYNCS
#define EXTRA_SYNCS 0
#endif
#ifndef REP_G2
#define REP_G2 1
#endif
#ifndef REP_CONV
#define REP_CONV 1
#endif
#ifndef REP_G4
#define REP_G4 1
#endif
__global__ void __launch_bounds__(NTHREADS, 2) fwd_kernel(Args a) {
    extern __shared__ __attribute__((aligned(16))) unsigned char lds_raw[];
    LAS unsigned char* lds = (LAS unsigned char*)lds_raw;
    cg::grid_group grid = cg::this_grid();
    const int G = gridDim.x, wg = blockIdx.x;
    unsigned char* ws = a.ws;
    float* ssqA = (float*)(ws + WS_SSQ); float* ssqB = (float*)(ws + WS_SSQ1);
    bf16_t* XB = (bf16_t*)(ws + WS_XB); bf16_t* O2 = (bf16_t*)(ws + WS_O2); bf16_t* BIG = (bf16_t*)(ws + WS_BIG);
    const int lo = a.ph_lo, hi = a.ph_hi;
    int pid = 0;
    if (threadIdx.x < 16) ((LAS unsigned*)(lds + LDS_BARST))[threadIdx.x] = 0u;
    __syncthreads();
    if (lo > hi) grid.sync();
    XcdBarrier bar = xcd_barrier_post((unsigned*)(ws + WS_BAR), (volatile LAS unsigned*)(lds + LDS_BARST));
#define PH_BEGIN if (pid >= lo && pid < hi) {
#define PH_END   if (pid + 1 < hi) xcd_barrier(bar); } ++pid;

    PH_BEGIN
for (int rep = 0; rep < REP_P0; ++rep) { p0_phase(a, lds, G, wg, 0, G >= 256); __syncthreads(); }
    for (int rep = 0; rep < EXTRA_SYNCS; ++rep) xcd_barrier(bar);
 PH_END

    for (int i = 0; i < DEPTH; ++i) {
        const int mixer = i % 3, j = i / 3;
        if (mixer != 2) {
            PH_BEGIN
            pg8::Gemm g; pg8::EpiAct E;
            if (mixer == 0) { g = pg8::Gemm{XB, (const bf16_t*)(ws + WS_AWIN) + (size_t)j * 4096 * DM, MT, 4096, DM, 0}; E = pg8::EpiAct{BIG, 4096, ssqA, 0, (const float*)(ws + WS_LB) + j * 1024, 1.f, nullptr, 0}; }
            else { g = pg8::Gemm{XB, (const bf16_t*)(ws + WS_BQKV), MT, 3072, DM, 0}; E = pg8::EpiAct{BIG, 3072, ssqA, 1, nullptr, 0.08838834764831845f * 1.4426950408889634f, (float*)(ws + WS_KMEAN), 0}; }
            pg8::StaticOrder S; S.init(g.M, g.N, G, wg);
            E.use_tab = build_rstd_table(lds, S, E.ssq) ? 1 : 0;
            for (int rep = 0; rep < REP_G1; ++rep) pg8::gemm_phase<pg8::EpiAct, pg8::StaticOrder, true, true>(lds, g, S, E);

            PH_END
        } else {
            PH_BEGIN for (int rep = 0; rep < REP_POOL; ++rep) pool_phase(lds, XB, ssqA, a.in[1] + i * DM, O2, G, wg); PH_END
        }
        if (mixer == 0) {
            PH_BEGIN
if ((i == 0 || i == 3) && G >= 256 && wg >= 128) { for (int rep = 0; rep < REP_CONV; ++rep) p0_phase(a, lds, G - 128, wg - 128, i == 0 ? 1 : 2, true); }
            else for (int rep = 0; rep < REP_GLA; ++rep) gla_phase(lds, BIG, a.in[6] + j * 128, O2, G, wg);
 PH_END
        } else if (mixer == 1) {
            PH_BEGIN
for (int rep = 0; rep < REP_ATTN; ++rep) attn_phase(lds, BIG, (const float*)(ws + WS_KMEAN), (const float*)(ws + WS_BIAST), O2, G, wg);
 PH_END
        }
        {
            PH_BEGIN
            pg8::Gemm g;
            if (mixer == 0) g = pg8::Gemm{O2, (const bf16_t*)(ws + WS_AWOUT) + (size_t)j * DM * DM, MT, DM, DM, 0};
            else if (mixer == 1) g = pg8::Gemm{O2, (const bf16_t*)(ws + WS_BOUT), MT, DM, DM, 0};
            else g = pg8::Gemm{O2, (const bf16_t*)(ws + WS_CW), MT, DM, 256, (size_t)MT * 256 * 2};
            pg8::EpiRes E{XB, ssqB, mixer == 2 ? a.in[12] + j * DM : nullptr, 0};
            pg8::StaticOrder S; S.init(g.M, g.N, G, wg);
            for (int rep = 1; rep < REP_G2; ++rep) { pg8::EpiRes Ed = E; Ed.dry = 1; pg8::gemm_phase<pg8::EpiRes, pg8::StaticOrder, true, true>(lds, g, S, Ed); }
            pg8::gemm_phase<pg8::EpiRes,  pg8::StaticOrder, true, true>(lds, g, S, E);

            PH_END
        }
        {
            PH_BEGIN
            pg8::Gemm g{XB, (const bf16_t*)(ws + WS_W1) + (size_t)i * FF * DM, MT, FF, DM, 0};
            pg8::EpiAct E{BIG, FF, ssqB, 2, nullptr, 1.f, nullptr, 0};
            pg8::StaticOrder S; S.init(g.M, g.N, G, wg);
            E.use_tab = build_rstd_table(lds, S, E.ssq) ? 1 : 0;
            for (int rep = 0; rep < REP_G3; ++rep) pg8::gemm_phase<pg8::EpiAct, pg8::StaticOrder, true, true>(lds, g, S, E);

            PH_END
        }
        {
            PH_BEGIN
            pg8::Gemm g{BIG, (const bf16_t*)(ws + WS_W2) + (size_t)i * DM * FF, MT, DM, FF, 0};
            pg8::EpiRes E{XB, ssqA, nullptr, 0};
            pg8::StaticOrder S; S.init(g.M, g.N, G, wg);
            for (int rep = 1; rep < REP_G4; ++rep) { pg8::EpiRes Ed = E; Ed.dry = 1; pg8::gemm_phase<pg8::EpiRes, pg8::StaticOrder, true, true>(lds, g, S, Ed); }
            pg8::gemm_phase<pg8::EpiRes, pg8::StaticOrder, true, true>(lds, g, S, E);

            PH_END
        }
    }
    PH_BEGIN final_phase(XB, a.out, ssqA, a.in[3], G, wg); PH_END
#undef PH_BEGIN
#undef PH_END
}

extern "C" void kernel_launch(void* const* d_in, const int* in_sizes, int n_in, void* d_out, int out_size, void* d_ws, size_t ws_size, hipStream_t stream) {
    static int grid = 0;
    if (grid == 0) {
        if (n_in != 15 || in_sizes[0] != MT * DM || out_size != MT * DM || ws_size < WS_END) { fprintf(stderr, "kernel_launch: unexpected shapes (n_in %d, in0 %d, out %d, ws %zu need %zu)\n", n_in, n_in > 0 ? in_sizes[0] : -1, out_size, ws_size, (size_t)WS_END); grid = -1; return; }
        int dev = 0, cus = 0, per_cu = 0;
        hipGetDevice(&dev); hipDeviceGetAttribute(&cus, hipDeviceAttributeMultiprocessorCount, dev);
        hipFuncSetAttribute((const void*)fwd_kernel, hipFuncAttributeMaxDynamicSharedMemorySize, LDS_BYTES);
        hipOccupancyMaxActiveBlocksPerMultiprocessor(&per_cu, (const void*)fwd_kernel, NTHREADS, LDS_BYTES);
        (void)hipGetLastError();
        if (per_cu < 1) per_cu = 1;
        grid = cus * per_cu;
        fprintf(stderr, "kernel_launch: grid %d (cus %d x %d)\n", grid, cus, per_cu);
    }
    if (grid < 0) return;
    Args a{};
    for (int i = 0; i < 15; ++i) a.in[i] = (const float*)d_in[i];
    a.out = (float*)d_out; a.ws = (unsigned char*)d_ws;
#if ONE_LAUNCH
    hipMemsetAsync((char*)d_ws + WS_BAR, 0, 16384, stream);
    a.ph_lo = 0; a.ph_hi = NPHASES;
    void* args[] = {&a};
    hipError_t e = hipLaunchCooperativeKernel((const void*)fwd_kernel, dim3(grid), dim3(NTHREADS), args, LDS_BYTES, stream);
    if (e != hipSuccess) fprintf(stderr, "cooperative launch failed: %s (grid %d)\n", hipGetErrorString(e), grid);
#else
    for (int p = 0; p < NPHASES; ++p) {
        a.ph_lo = p; a.ph_hi = p + 1;
        hipLaunchKernelGGL(fwd_kernel, dim3(grid), dim3(NTHREADS), LDS_BYTES, stream, a);
    }
#endif
}
```
